# Optimizing an MI355X kernel written in HIP

```python
import jax, jax.numpy as jnp
from jax import lax
import numpy as np

D_MODEL = 2048
BATCH = 4
SEQ = 4096
DEPTH = 2

N_MIXERS = 2
D_MIX = D_MODEL
MEM_LEN = 256
MEM_HEADS = 4
MEM_HD = 128
MEM_W = MEM_HEADS * MEM_HD
TOK_W = D_MIX - MEM_W
SB_HD = 128
SB_HEADS = TOK_W // SB_HD
SB_BLOCK = 128
SWA_HD = 64
SWA_HEADS = TOK_W // SWA_HD
SWA_GROUP = 8
SWA_KV_HEADS = SWA_HEADS // SWA_GROUP
WINDOW = 128
ROPE_THETA = 10000.0
D_FF = 5632
NORM_EPS = 1e-6
N_SB_LAYERS = (DEPTH + 1) // 2
N_SWA_LAYERS = DEPTH // 2
SB_IN_W = 3 * TOK_W + MEM_W
SWA_IN_W = TOK_W + 2 * SWA_KV_HEADS * SWA_HD + MEM_W

kernel_name = 'hybrid_stickbreaking_swa_sink_macaron_memory'


def rmsnorm(x, g):
    xf = x.astype(jnp.float32)
    y = xf * lax.rsqrt(jnp.mean(xf * xf, axis=-1, keepdims=True) + NORM_EPS)
    return (y * g.astype(jnp.float32)).astype(x.dtype)


def swiglu(x, w_gate, w_up, w_down):
    return (jax.nn.silu(x @ w_gate) * (x @ w_up)) @ w_down


def rope(x, positions):
    half = x.shape[-1] // 2
    inv_freq = ROPE_THETA ** (-jnp.arange(half, dtype=jnp.float32) / half)
    ang = positions.astype(jnp.float32)[..., None] * inv_freq
    cos = jnp.cos(ang)[:, :, None, :]
    sin = jnp.sin(ang)[:, :, None, :]
    x1 = x[..., :half].astype(jnp.float32)
    x2 = x[..., half:].astype(jnp.float32)
    out = jnp.concatenate([x1 * cos - x2 * sin, x2 * cos + x1 * sin], axis=-1)
    return out.astype(x.dtype)


def stick_breaking_attention(q, k, v):
    S = q.shape[1]
    scale = SB_HD ** -0.5
    outs = []
    for i in range(S // SB_BLOCK):
        kv_len = (i + 1) * SB_BLOCK
        q_blk = q[:, i * SB_BLOCK:kv_len]
        k_blk = k[:, :kv_len]
        v_blk = v[:, :kv_len]
        z = jnp.einsum('bthd,bshd->bhts', q_blk, k_blk).astype(jnp.float32) * scale
        t_idx = i * SB_BLOCK + jnp.arange(SB_BLOCK)[:, None]
        s_idx = jnp.arange(kv_len)[None, :]
        causal = s_idx < t_idx
        log1m = jnp.where(causal, -jax.nn.softplus(z), 0.0)
        suffix = lax.cumsum(log1m, axis=3, reverse=True)
        log_a = jax.nn.log_sigmoid(z) + (suffix - log1m)
        a = jnp.where(causal, jnp.exp(log_a), 0.0)
        outs.append(jnp.einsum('bhts,bshd->bthd', a.astype(v.dtype), v_blk))
    return jnp.concatenate(outs, axis=1)


def sliding_window_sink_attention(q, k, v, sinks):
    B, S = q.shape[:2]
    nb = S // WINDOW
    qb = q.reshape(B, nb, WINDOW, SWA_KV_HEADS, SWA_GROUP, SWA_HD)

    def with_prev(t):
        tb = t.reshape(B, nb, WINDOW, SWA_KV_HEADS, SWA_HD)
        prev = jnp.pad(tb, ((0, 0), (1, 0), (0, 0), (0, 0), (0, 0)))[:, :-1]
        return jnp.concatenate([prev, tb], axis=2)

    kb, vb = with_prev(k), with_prev(v)
    z = jnp.einsum('bnqhgd,bnkhd->bnhgqk', qb, kb).astype(jnp.float32) * SWA_HD ** -0.5
    qi = jnp.arange(WINDOW)[:, None]
    ki = jnp.arange(2 * WINDOW)[None, :]
    dist = qi + WINDOW - ki
    key_pos = jnp.arange(nb)[:, None, None] * WINDOW - WINDOW + ki
    valid = (dist >= 0) & (dist < WINDOW) & (key_pos >= 0)
    valid = valid[None, :, None, None]
    z = jnp.where(valid, z, -jnp.inf)
    sink = sinks.astype(jnp.float32).reshape(1, 1, SWA_KV_HEADS, SWA_GROUP, 1, 1)
    m = jnp.maximum(jnp.max(z, axis=-1, keepdims=True), sink)
    p = jnp.exp(z - m)
    p = p / (jnp.sum(p, axis=-1, keepdims=True) + jnp.exp(sink - m))
    out = jnp.einsum('bnhgqk,bnkhd->bnqhgd', p.astype(v.dtype), vb)
    return out.reshape(B, S, SWA_HEADS, SWA_HD)


def memory_attention(qm, mem_n, w_mem_kv, q_g, k_g):
    B, M = mem_n.shape[:2]
    kv = (mem_n @ w_mem_kv).reshape(B, M, 2, MEM_HEADS, MEM_HD)
    km = rmsnorm(kv[:, :, 0], k_g)
    vm = kv[:, :, 1]
    qm = rmsnorm(qm, q_g)
    z = jnp.einsum('bthd,bmhd->bhtm', qm, km).astype(jnp.float32) * MEM_HD ** -0.5
    p = jax.nn.softmax(z, axis=-1)
    return jnp.einsum('bhtm,bmhd->bthd', p.astype(vm.dtype), vm)


def setup_inputs(seed: int = 0) -> dict:
    key = jax.random.key(seed)
    ks = jax.random.split(key, 20)

    def nrm(k, shape, scale):
        return jax.random.normal(k, shape, jnp.float32) * scale

    def gain(k, shape):
        return 1.0 + 0.1 * jax.random.normal(k, shape, jnp.float32)

    x = jax.random.normal(ks[0], (BATCH, SEQ, D_MODEL), jnp.float32)
    mem = jax.random.normal(ks[1], (BATCH, MEM_LEN, D_MODEL), jnp.float32)
    offset = jax.random.randint(ks[2], (BATCH, 1), 0, 1024, jnp.int32)
    positions = offset + jnp.arange(SEQ, dtype=jnp.int32)[None, :]
    return {
        'x': x,
        'mem': mem,
        'positions': positions,
        'ffn_norm_g': gain(ks[3], (DEPTH, 2, D_MODEL)),
        'ffn_w_gate': nrm(ks[4], (DEPTH, 2, D_MODEL, D_FF), D_MODEL ** -0.5),
        'ffn_w_up': nrm(ks[5], (DEPTH, 2, D_MODEL, D_FF), D_MODEL ** -0.5),
        'ffn_w_down': nrm(ks[6], (DEPTH, 2, D_FF, D_MODEL), D_FF ** -0.5),
        'mix_norm_g': gain(ks[7], (DEPTH, D_MODEL)),
        'mem_norm_g': gain(ks[8], (DEPTH, D_MODEL)),
        'w_mem_kv': nrm(ks[9], (DEPTH, D_MODEL, 2 * MEM_W), D_MODEL ** -0.5),
        'memq_norm_g': gain(ks[10], (DEPTH, MEM_HD)),
        'memk_norm_g': gain(ks[11], (DEPTH, MEM_HD)),
        'w_out': nrm(ks[12], (DEPTH, D_MIX, D_MODEL), D_MIX ** -0.5),
        'sb_w_in': nrm(ks[13], (N_SB_LAYERS, D_MODEL, SB_IN_W), D_MODEL ** -0.5),
        'swa_w_in': nrm(ks[14], (N_SWA_LAYERS, D_MODEL, SWA_IN_W), D_MODEL ** -0.5),
        'swa_q_norm_g': gain(ks[15], (N_SWA_LAYERS, SWA_HD)),
        'swa_k_norm_g': gain(ks[16], (N_SWA_LAYERS, SWA_HD)),
        'swa_sinks': nrm(ks[17], (N_SWA_LAYERS, SWA_HEADS), 0.5),
    }


def reference(x, mem, positions, ffn_norm_g, ffn_w_gate, ffn_w_up, ffn_w_down, mix_norm_g, mem_norm_g,
              w_mem_kv, memq_norm_g, memk_norm_g, w_out, sb_w_in, swa_w_in, swa_q_norm_g, swa_k_norm_g,
              swa_sinks):
    B, S, _ = x.shape
    kv_w = SWA_KV_HEADS * SWA_HD
    for i in range(DEPTH):
        h = rmsnorm(x, ffn_norm_g[i, 0])
        x = x + 0.5 * swiglu(h, ffn_w_gate[i, 0], ffn_w_up[i, 0], ffn_w_down[i, 0])

        h = rmsnorm(x, mix_norm_g[i])
        mem_n = rmsnorm(mem, mem_norm_g[i])
        j = i // N_MIXERS
        if i % N_MIXERS == 0:
            proj = h @ sb_w_in[j]
            q, k, v, qm = jnp.split(proj, [TOK_W, 2 * TOK_W, 3 * TOK_W], axis=-1)
            tok = stick_breaking_attention(q.reshape(B, S, SB_HEADS, SB_HD),
                                           k.reshape(B, S, SB_HEADS, SB_HD),
                                           v.reshape(B, S, SB_HEADS, SB_HD))
        else:
            proj = h @ swa_w_in[j]
            q, k, v, qm = jnp.split(proj, [TOK_W, TOK_W + kv_w, TOK_W + 2 * kv_w], axis=-1)
            q = rope(rmsnorm(q.reshape(B, S, SWA_HEADS, SWA_HD), swa_q_norm_g[j]), positions)
            k = rope(rmsnorm(k.reshape(B, S, SWA_KV_HEADS, SWA_HD), swa_k_norm_g[j]), positions)
            tok = sliding_window_sink_attention(q, k, v.reshape(B, S, SWA_KV_HEADS, SWA_HD), swa_sinks[j])
        memo = memory_attention(qm.reshape(B, S, MEM_HEADS, MEM_HD), mem_n, w_mem_kv[i],
                                memq_norm_g[i], memk_norm_g[i])
        mixed = jnp.concatenate([tok.reshape(B, S, TOK_W), memo.reshape(B, S, MEM_W)], axis=-1)
        x = x + mixed @ w_out[i]

        h = rmsnorm(x, ffn_norm_g[i, 1])
        x = x + 0.5 * swiglu(h, ffn_w_gate[i, 1], ffn_w_up[i, 1], ffn_w_down[i, 1])
    return x
```

```cpp
#include <hip/hip_runtime.h>
#include <cstdio>
#include <cstdint>
#include <cstring>
constexpr int D_MODEL = 2048, BATCH = 4, SEQ = 4096, DEPTH = 2;
constexpr int M = BATCH * SEQ;
constexpr int MEM_LEN = 256, MEM_HEADS = 4, MEM_HD = 128, MEM_W = 512, TOK_W = 1536;
constexpr int SB_HD = 128, SB_HEADS = 12, SWA_HD = 64, SWA_HEADS = 24, SWA_GROUP = 8, SWA_KV_HEADS = 3, WINDOW = 128;
constexpr int D_FF = 5632;
constexpr int SB_IN_W = 3 * TOK_W + MEM_W;
constexpr int SWA_IN_W = TOK_W + 2 * SWA_KV_HEADS * SWA_HD + MEM_W;
constexpr float NORM_EPS = 1e-6f;
constexpr int MROWS = BATCH * MEM_LEN;
#define LAS __attribute__((address_space(3)))
#ifndef PG8_LATE
#define PG8_LATE 0
#endif
namespace pg8 {
#define PG8_LAS __attribute__((address_space(3)))
typedef unsigned short bf16_t;
typedef short bf16x8 __attribute__((ext_vector_type(8)));
typedef float f32x4 __attribute__((ext_vector_type(4)));
typedef unsigned u32x4 __attribute__((ext_vector_type(4)));
constexpr int BM = 256, BK = 64, HALF = 128, HTB = HALF * BK * 2  , STAGE_BYTES = 8 * HTB, NXCD = 8, WGM = 8;

__host__ __device__ __forceinline__ int lds_byte(int r, int c) { const int st = (r >> 4) * 2 + (c >> 5), rr = r & 15, cc = c & 31, ob = rr * 64 + cc * 2; return st * 1024 + (ob ^ (((ob >> 9) & 1) << 5)); }
__host__ __device__ __forceinline__ void stage_rc(int b, int& R, int& C) { const int st = b / 1024, sb = b % 1024, swz = sb ^ (((sb >> 9) & 1) << 5); R = (st >> 1) * 16 + swz / 64; C = (st & 1) * 32 + (swz % 64) / 2; }
__host__ __device__ __forceinline__ int perm32(int rho) { const int n = rho >> 4, i = rho & 15; return 8 * (i >> 2) + 4 * n + (i & 3); }

struct Unit { int pm, pn; };
struct Gemm { const bf16_t* A; const bf16_t* Bt; int M, N, K; };

struct StaticOrder {
    int nM, nN, nwg, G, c, wgm = WGM, rev = 0;
    __host__ __device__ void init(int M, int N, int G_, int c_, int wgm_ = WGM, int rev_ = 0) { nM = M / BM; nN = N / BM; nwg = nM * nN; G = G_; c = c_; wgm = wgm_; rev = rev_; }
    __host__ __device__ bool next(int i, Unit& u) const {
        const long L = (long)i * G + c; if (L >= nwg) return false;
        int wgid = (int)L; { const int q = nwg / NXCD, r = nwg % NXCD, xcd = wgid % NXCD, off = wgid / NXCD; wgid = (xcd < r ? xcd * (q + 1) : r * (q + 1) + (xcd - r) * q) + off; }
        const int nig = wgm * nN, gid = wgid / nig, fm = gid * wgm, gsz = (nM - fm) < wgm ? (nM - fm) : wgm;
        u.pm = fm + ((wgid % nig) % gsz); u.pn = (wgid % nig) / gsz; if (rev) u.pm = nM - 1 - u.pm; return true;
    }
    __device__ __forceinline__ void a_ready(const Unit&) const {}
    __device__ __forceinline__ void done(const Unit&) const {}
};
__device__ __forceinline__ unsigned cvt_pk_bf16(float lo, float hi) { unsigned r; asm volatile("v_cvt_pk_bf16_f32 %0, %1, %2" : "=v"(r) : "v"(lo), "v"(hi)); return r; }
typedef float f32x2 __attribute__((ext_vector_type(2)));
__device__ __forceinline__ float silu_mul(float g, float u) { return g * u * __builtin_amdgcn_rcpf(1.0f + __builtin_amdgcn_exp2f(-1.4426950408889634f * g)); }
__device__ __forceinline__ float bf_lo(unsigned w) { return __uint_as_float(w << 16); }
__device__ __forceinline__ float bf_hi(unsigned w) { return __uint_as_float(w & 0xffff0000u); }
__device__ __forceinline__ void load_rstd(const float* ss, int row0, float eps, float (&rs)[2][4]) {
#pragma unroll
    for (int ai = 0; ai < 2; ++ai) { f32x4 a[4], b[4];
#pragma unroll
        for (int m = 0; m < 4; ++m) { const float* p = ss + (size_t)(row0 + ai * HALF + m * 16) * 8; a[m] = *(const f32x4*)p; b[m] = *(const f32x4*)(p + 4); }
#pragma unroll
        for (int m = 0; m < 4; ++m) { const f32x4 x = a[m], y = b[m];
            rs[ai][m] = __builtin_amdgcn_rsqf((((x[0] + x[1]) + (x[2] + x[3])) + ((y[0] + y[1]) + (y[2] + y[3]))) * (1.0f / 2048.0f) + eps); } }
}
struct RstdCache { mutable int pm = -1; mutable float rs[2][4];
    __device__ __forceinline__ void get(const float* ss, const Unit& u, int row0, float eps) const { if (u.pm != pm) { load_rstd(ss, row0, eps, rs); pm = u.pm; } } };
struct EpiSwiGLU {
    static constexpr bool PERM = true, AFTER_DRAIN = false;
    bf16_t* O; int ldc; const float* ss; float eps; RstdCache rc;
    static __device__ __forceinline__ f32x2 act2(f32x2 g, f32x2 u, float r) { g = g * r; u = u * r; const f32x2 t = g * (-1.4426950408889634f);
        f32x2 e; e.x = __builtin_amdgcn_exp2f(t.x); e.y = __builtin_amdgcn_exp2f(t.y); e = e + 1.0f;
        f32x2 q; q.x = __builtin_amdgcn_rcpf(e.x); q.y = __builtin_amdgcn_rcpf(e.y); return (g * u) * q; }
    __device__ __forceinline__ void operator()(const f32x4 (&acc)[2][2][4][2], const Unit& u, int wr, int wc, int fr, int fq) const {
        const int row0 = u.pm * BM + wr * 64 + fr, col0 = u.pn * HALF + wc * 32 + 8 * fq;
        rc.get(ss, u, row0, eps); const float (&rs)[2][4] = rc.rs;
#pragma unroll
        for (int ai = 0; ai < 2; ++ai)
#pragma unroll
            for (int m = 0; m < 4; ++m) { bf16_t* rowp = O + (size_t)(row0 + ai * HALF + m * 16) * ldc + col0; const float r = rs[ai][m];
                const f32x4 g0 = acc[ai][0][m][0], g1 = acc[ai][0][m][1], u0 = acc[ai][1][m][0], u1 = acc[ai][1][m][1];
                const f32x2 a = act2((f32x2){g0[0], g0[1]}, (f32x2){u0[0], u0[1]}, r), b = act2((f32x2){g0[2], g0[3]}, (f32x2){u0[2], u0[3]}, r);
                const f32x2 c = act2((f32x2){g1[0], g1[1]}, (f32x2){u1[0], u1[1]}, r), d = act2((f32x2){g1[2], g1[3]}, (f32x2){u1[2], u1[3]}, r);
                u32x4 w; w.x = cvt_pk_bf16(a.x, a.y); w.y = cvt_pk_bf16(b.x, b.y); w.z = cvt_pk_bf16(c.x, c.y); w.w = cvt_pk_bf16(d.x, d.y);
                *(u32x4*)rowp = w; }
    }
};
template <bool FINAL> struct EpiResidB {
    static constexpr bool PERM = true, AFTER_DRAIN = false;
    bf16_t* XB; float* outf; float* ss; PG8_LAS float* tab; int ldc; float alpha;
    __device__ __forceinline__ void operator()(const f32x4 (&acc)[2][2][4][2], const Unit& u, int wr, int wc, int fr, int fq) const {
        const int row0 = u.pm * BM + wr * 64 + fr, col0 = u.pn * BM + wc * 32 + 8 * fq;
        u32x4 xv[2][4][2];
#pragma unroll
        for (int ai = 0; ai < 2; ++ai)
#pragma unroll
            for (int m = 0; m < 4; ++m)
#pragma unroll
                for (int bj = 0; bj < 2; ++bj) xv[ai][m][bj] = *(const u32x4*)(XB + (size_t)(row0 + ai * HALF + m * 16) * ldc + col0 + bj * HALF);
#pragma unroll
        for (int ai = 0; ai < 2; ++ai)
#pragma unroll
            for (int m = 0; m < 4; ++m) { const size_t off = (size_t)(row0 + ai * HALF + m * 16) * ldc + col0; float s = 0.f;
#pragma unroll
                for (int bj = 0; bj < 2; ++bj) { const u32x4 x = xv[ai][m][bj]; const f32x4 a0 = acc[ai][bj][m][0] * alpha, a1 = acc[ai][bj][m][1] * alpha;
                    const f32x4 v0 = {bf_lo(x.x) + a0[0], bf_hi(x.x) + a0[1], bf_lo(x.y) + a0[2], bf_hi(x.y) + a0[3]};
                    const f32x4 v1 = {bf_lo(x.z) + a1[0], bf_hi(x.z) + a1[1], bf_lo(x.w) + a1[2], bf_hi(x.w) + a1[3]};
                    if constexpr (FINAL) { *(f32x4*)(outf + off + bj * HALF) = v0; *(f32x4*)(outf + off + bj * HALF + 4) = v1; }
                    else { s += ((v0[0] * v0[0] + v0[1] * v0[1]) + (v0[2] * v0[2] + v0[3] * v0[3])) + ((v1[0] * v1[0] + v1[1] * v1[1]) + (v1[2] * v1[2] + v1[3] * v1[3]));
                        u32x4 w; w.x = cvt_pk_bf16(v0[0], v0[1]); w.y = cvt_pk_bf16(v0[2], v0[3]); w.z = cvt_pk_bf16(v1[0], v1[1]); w.w = cvt_pk_bf16(v1[2], v1[3]);
                        *(u32x4*)(XB + off + bj * HALF) = w; } }
                if constexpr (!FINAL) { s += __shfl_xor(s, 16); s += __shfl_xor(s, 32); if (fq == 0) tab[(ai * HALF + wr * 64 + m * 16 + fr) * 4 + wc] = s; } }
        if constexpr (!FINAL) {
            asm volatile("s_waitcnt lgkmcnt(0)" ::: "memory"); __builtin_amdgcn_s_barrier(); asm volatile("" ::: "memory");
            const int t = threadIdx.x;
            if (t < BM) { const f32x4 p = *(const PG8_LAS f32x4*)(tab + t * 4); ss[(size_t)(u.pm * BM + t) * 8 + u.pn] = (p[0] + p[1]) + (p[2] + p[3]); }
        }
    }
};
struct EpiBf16S {
    static constexpr bool PERM = true, AFTER_DRAIN = false;
    bf16_t* O; int ldc; int q_tiles; float qscale; const float* ss; float eps; RstdCache rc;
    __device__ __forceinline__ void operator()(const f32x4 (&acc)[2][2][4][2], const Unit& u, int wr, int wc, int fr, int fq) const {
        const int row0 = u.pm * BM + wr * 64 + fr, col0 = u.pn * BM + wc * 32 + 8 * fq; const float sc = u.pn < q_tiles ? qscale : 1.f;
        if (ss) rc.get(ss, u, row0, eps);
        else if (rc.pm != -2) { rc.pm = -2;
#pragma unroll
            for (int ai = 0; ai < 2; ++ai)
#pragma unroll
                for (int m = 0; m < 4; ++m) rc.rs[ai][m] = 1.f; }
        const float (&rs)[2][4] = rc.rs;
#pragma unroll
        for (int ai = 0; ai < 2; ++ai)
#pragma unroll
            for (int m = 0; m < 4; ++m) { bf16_t* rowp = O + (size_t)(row0 + ai * HALF + m * 16) * ldc + col0; const float r = rs[ai][m] * sc;
#pragma unroll
                for (int bj = 0; bj < 2; ++bj) { const f32x4 v0 = acc[ai][bj][m][0] * r, v1 = acc[ai][bj][m][1] * r;
                    u32x4 w; w.x = cvt_pk_bf16(v0[0], v0[1]); w.y = cvt_pk_bf16(v0[2], v0[3]); w.z = cvt_pk_bf16(v1[0], v1[1]); w.w = cvt_pk_bf16(v1[2], v1[3]);
                    *(u32x4*)(rowp + bj * HALF) = w; } }
    }
};
struct EpiProjSWA {
    static constexpr bool PERM = true, AFTER_DRAIN = false;
    bf16_t* O; int ldc; const float* qg; const float* kg; const int* pos; float qscale; float eps; const float* ss;
    __device__ __forceinline__ void operator()(const f32x4 (&acc)[2][2][4][2], const Unit& u, int wr, int wc, int fr, int fq) const {
        const int pn = u.pn, row0 = u.pm * BM + wr * 64 + fr;
        if (pn == 6 && wc == 3) return;
        const float* g = pn < 6 ? qg : kg; const float sc = pn < 6 ? qscale : 1.f;
        const int colbase = (pn < 6 ? (4 * pn + wc) * 64 : 1536 + wc * 64) + 8 * fq;
        f32x4 gv[2][2];
        if (pn <= 6) {
#pragma unroll
            for (int bj = 0; bj < 2; ++bj)
#pragma unroll
                for (int n = 0; n < 2; ++n) gv[bj][n] = *(const f32x4*)(g + 32 * bj + 8 * fq + 4 * n); }
#pragma unroll
        for (int ai = 0; ai < 2; ++ai) {
            float rs[4]; int pv[4];
            { f32x4 a[4], b[4];
#pragma unroll
              for (int m = 0; m < 4; ++m) { const int r = row0 + ai * HALF + m * 16; const float* p = ss + (size_t)r * 8; a[m] = *(const f32x4*)p; b[m] = *(const f32x4*)(p + 4); pv[m] = pos[r]; }
#pragma unroll
              for (int m = 0; m < 4; ++m) { const f32x4 x = a[m], y = b[m];
                  rs[m] = __builtin_amdgcn_rsqf((((x[0] + x[1]) + (x[2] + x[3])) + ((y[0] + y[1]) + (y[2] + y[3]))) * (1.0f / 2048.0f) + eps); } }
            if (pn <= 6) {
#pragma unroll
                for (int m = 0; m < 4; ++m) { const int r = row0 + ai * HALF + m * 16; const float rr = rs[m], pf = (float)pv[m];
                    float ss2 = 0.f;
#pragma unroll
                    for (int bj = 0; bj < 2; ++bj)
#pragma unroll
                        for (int n = 0; n < 2; ++n) { const f32x4 x = acc[ai][bj][m][n]; ss2 += (x[0] * x[0] + x[1] * x[1]) + (x[2] * x[2] + x[3] * x[3]); }
                    ss2 += __shfl_xor(ss2, 16); ss2 += __shfl_xor(ss2, 32);
                    const float rstd = __builtin_amdgcn_rsqf(ss2 * rr * rr * (1.0f / 64.0f) + eps) * sc * rr;
                    u32x4 w1, w2;
#pragma unroll
                    for (int n = 0; n < 2; ++n) { f32x4 c, s;
#pragma unroll
                        for (int j = 0; j < 4; ++j) { const float fi = __builtin_amdgcn_exp2f(-0.41524101186092029f * (float)(8 * fq + 4 * n + j)) * 0.15915494309189535f;
                            const float t = __builtin_amdgcn_fractf(pf * fi); c[j] = __builtin_amdgcn_cosf(t); s[j] = __builtin_amdgcn_sinf(t); }
                        const f32x4 x1 = acc[ai][0][m][n] * gv[0][n] * rstd, x2 = acc[ai][1][m][n] * gv[1][n] * rstd;
                        const f32x4 o1 = x1 * c - x2 * s, o2 = x2 * c + x1 * s;
                        if (n == 0) { w1.x = cvt_pk_bf16(o1[0], o1[1]); w1.y = cvt_pk_bf16(o1[2], o1[3]); w2.x = cvt_pk_bf16(o2[0], o2[1]); w2.y = cvt_pk_bf16(o2[2], o2[3]); }
                        else        { w1.z = cvt_pk_bf16(o1[0], o1[1]); w1.w = cvt_pk_bf16(o1[2], o1[3]); w2.z = cvt_pk_bf16(o2[0], o2[1]); w2.w = cvt_pk_bf16(o2[2], o2[3]); } }
                    bf16_t* rowp = O + (size_t)r * ldc + colbase;
                    *(u32x4*)rowp = w1; *(u32x4*)(rowp + 32) = w2; }
            } else {
#pragma unroll
                for (int bj = 0; bj < 2; ++bj) { const int p = bj * HALF + wc * 32 + 8 * fq;
                    if (pn == 7 && p >= 192) continue;
                    const int col = pn == 7 ? 1728 + p : 1920 + (pn - 8) * 256 + p;
#pragma unroll
                    for (int m = 0; m < 4; ++m) { const float rr = rs[m]; const f32x4 v0 = acc[ai][bj][m][0] * rr, v1 = acc[ai][bj][m][1] * rr;
                        u32x4 w; w.x = cvt_pk_bf16(v0[0], v0[1]); w.y = cvt_pk_bf16(v0[2], v0[3]); w.z = cvt_pk_bf16(v1[0], v1[1]); w.w = cvt_pk_bf16(v1[2], v1[3]);
                        *(u32x4*)(O + (size_t)(row0 + ai * HALF + m * 16) * ldc + col) = w; } }
            }
        }
    }
};
template <class Epi, class Sched, bool ALIGN_EPI = false, bool SP2 = false>
__device__ __forceinline__ void gemm_phase(PG8_LAS unsigned char* lds, const Gemm g, const Sched& S, const Epi& E) {
    const int tid = threadIdx.x, wid = __builtin_amdgcn_readfirstlane(tid >> 6), lane = tid & 63, wr = wid >> 2, wc = wid & 3, fr = lane & 15, fq = lane >> 4;
    const int K = g.K, nt = K / BK;
    unsigned voffA[2], voffB[2];
#pragma unroll
    for (int i = 0; i < 2; ++i) { int R, C; stage_rc(tid * 16 + i * 8192, R, C); const int Rb = Epi::PERM ? ((R & ~31) + perm32(R & 31)) : R;
        voffA[i] = (unsigned)(R * K + C) * 2u; voffB[i] = (unsigned)((C >> 4) * (BM * 16) + Rb * 16 + (C & 15)) * 2u; }
    const size_t kstep = (size_t)(BK * 2);
    const size_t kstepB = (size_t)BM * BK * 2, hstepB = (size_t)HALF * 16 * 2;
    const size_t hstep = (size_t)HALF * K * 2;
    const size_t tstep = 2 * hstep;
    const unsigned ldsw = (unsigned)wid * 1024u;
    const int aoff = lds_byte(wr * 64 + fr, fq * 8), boff = lds_byte(wc * 32 + fr, fq * 8);
#define PG8_SA(b, h) (((b) * 2 + (h)) * HTB)
#define PG8_SB(b, h) ((4 + (b) * 2 + (h)) * HTB)
#define PG8_STAGE(bufoff, gbase, voff) do { _Pragma("unroll") for (int _i = 0; _i < 2; ++_i) \
        __builtin_amdgcn_global_load_lds((const unsigned*)((const char*)(gbase) + (voff)[_i]), (PG8_LAS unsigned*)(lds + (bufoff) + ldsw + _i * 8192), 16, 0, 0); } while (0)
#define PG8_LDA(dst, b, h) do { _Pragma("unroll") for (int m = 0; m < 4; ++m) _Pragma("unroll") for (int k = 0; k < 2; ++k) dst[m][k] = *(const PG8_LAS bf16x8*)(lds + PG8_SA(b, h) + aoff + m * 2048 + k * 1024); } while (0)
#define PG8_LDB(dst, b, h) do { _Pragma("unroll") for (int n = 0; n < 2; ++n) _Pragma("unroll") for (int k = 0; k < 2; ++k) dst[n][k] = *(const PG8_LAS bf16x8*)(lds + PG8_SB(b, h) + boff + n * 2048 + k * 1024); } while (0)
#define PG8_MMA(ai, bj, At, Bt) do { __builtin_amdgcn_s_setprio(1); _Pragma("unroll") for (int m = 0; m < 4; ++m) _Pragma("unroll") for (int n = 0; n < 2; ++n) _Pragma("unroll") for (int k = 0; k < 2; ++k) \
        acc[ai][bj][m][n] = __builtin_amdgcn_mfma_f32_16x16x32_bf16(Bt[n][k], At[m][k], acc[ai][bj][m][n], 0, 0, 0); __builtin_amdgcn_s_setprio(0); } while (0)
#define PG8_WAIT_V(n) asm volatile("s_waitcnt vmcnt(" #n ")" ::: "memory")
#define PG8_WAIT_L(n) asm volatile("s_waitcnt lgkmcnt(" #n ")" ::: "memory")
#define PG8_BAR __builtin_amdgcn_s_barrier()
#define PG8_SCHED __builtin_amdgcn_sched_barrier(0)
    Unit cur, nxt; int ui = 0;
    if (!S.next(0, cur)) return;
    f32x4 acc[2][2][4][2];
#pragma unroll
    for (int a = 0; a < 2; ++a)
#pragma unroll
        for (int b = 0; b < 2; ++b)
#pragma unroll
            for (int m = 0; m < 4; ++m)
#pragma unroll
                for (int n = 0; n < 2; ++n) acc[a][b][m][n] = (f32x4){0.f, 0.f, 0.f, 0.f};
    bf16x8 At[4][2], B0[2][2], B1[2][2];
    const char* cA = (const char*)g.A + (size_t)cur.pm * tstep; const char* cB = (const char*)g.Bt + (size_t)cur.pn * tstep;
    S.a_ready(cur);
    if constexpr (SP2) {
        PG8_STAGE(PG8_SB(0, 0), cB, voffB); PG8_STAGE(PG8_SB(0, 1), cB + hstepB, voffB); PG8_STAGE(PG8_SA(0, 0), cA, voffA); PG8_STAGE(PG8_SA(0, 1), cA + hstep, voffA);
        if (wr == 1) PG8_BAR;
        PG8_WAIT_V(2); PG8_BAR;
        PG8_STAGE(PG8_SB(1, 0), cB + kstepB, voffB); PG8_STAGE(PG8_SA(1, 0), cA + kstep, voffA); PG8_STAGE(PG8_SB(1, 1), cB + hstepB + kstepB, voffB);
        PG8_WAIT_V(6); PG8_BAR;
    } else {
        PG8_STAGE(PG8_SB(0, 0), cB, voffB); PG8_STAGE(PG8_SA(0, 0), cA, voffA); PG8_STAGE(PG8_SB(0, 1), cB + hstepB, voffB); PG8_STAGE(PG8_SA(0, 1), cA + hstep, voffA);
        if (wr == 1) PG8_BAR;
        PG8_WAIT_V(4); PG8_BAR;
        PG8_STAGE(PG8_SB(1, 0), cB + kstepB, voffB); PG8_STAGE(PG8_SA(1, 0), cA + kstep, voffA); PG8_STAGE(PG8_SB(1, 1), cB + hstepB + kstepB, voffB);
        PG8_WAIT_V(6); PG8_BAR;
    }
    for (;;) {
        const bool has_next = S.next(ui + 1, nxt);
        const char* nA = has_next ? (const char*)g.A + (size_t)nxt.pm * tstep : cA; const char* nB = has_next ? (const char*)g.Bt + (size_t)nxt.pn * tstep : cB;
        for (int t = 0; t < nt; t += 2) {
            const bool last = (t == nt - 2);
            const char* a1 = cA + (size_t)(t + 1) * kstep;
            const char* a2 = last ? nA : cA + (size_t)(t + 2) * kstep; const char* b2 = last ? nB : cB + (size_t)(t + 2) * kstepB;
            const char* a3 = a2 + kstep; const char* b3 = b2 + kstepB;
            if (last && has_next) S.a_ready(nxt);
            if constexpr (SP2) {
            PG8_LDB(B0, 0, 0); PG8_LDB(B1, 0, 1); PG8_SCHED; PG8_LDA(At, 0, 0); PG8_STAGE(PG8_SA(1, 1), a1 + hstep, voffA);
            PG8_WAIT_V(8); PG8_WAIT_L(0); PG8_BAR; PG8_MMA(0, 0, At, B0); PG8_MMA(0, 1, At, B1); PG8_BAR; PG8_SCHED;
#if PG8_LATE == 2
            PG8_LDA(At, 0, 1); PG8_STAGE(PG8_SB(0, 0), b2, voffB);
            PG8_WAIT_V(4); PG8_WAIT_L(0); PG8_BAR; PG8_MMA(1, 0, At, B0); PG8_SCHED; PG8_STAGE(PG8_SB(0, 1), b2 + hstepB, voffB); PG8_STAGE(PG8_SA(0, 0), a2, voffA); PG8_SCHED; PG8_MMA(1, 1, At, B1); PG8_BAR; PG8_SCHED;
#elif PG8_LATE == 1
            PG8_LDA(At, 0, 1); PG8_STAGE(PG8_SB(0, 0), b2, voffB); PG8_STAGE(PG8_SB(0, 1), b2 + hstepB, voffB);
            PG8_WAIT_V(6); PG8_WAIT_L(0); PG8_BAR; PG8_MMA(1, 0, At, B0); PG8_SCHED; PG8_STAGE(PG8_SA(0, 0), a2, voffA); PG8_SCHED; PG8_MMA(1, 1, At, B1); PG8_BAR; PG8_SCHED;
#else
            PG8_LDA(At, 0, 1); PG8_STAGE(PG8_SB(0, 0), b2, voffB); PG8_STAGE(PG8_SB(0, 1), b2 + hstepB, voffB); PG8_STAGE(PG8_SA(0, 0), a2, voffA);
            PG8_WAIT_V(8); PG8_WAIT_L(0); PG8_BAR; PG8_MMA(1, 0, At, B0); PG8_MMA(1, 1, At, B1); PG8_BAR; PG8_SCHED;
#endif
            PG8_LDB(B0, 1, 0); PG8_LDB(B1, 1, 1); PG8_SCHED; PG8_LDA(At, 1, 0); PG8_STAGE(PG8_SA(0, 1), a2 + hstep, voffA);
            PG8_WAIT_V(8); PG8_WAIT_L(0); PG8_BAR; PG8_MMA(0, 0, At, B0); PG8_MMA(0, 1, At, B1); PG8_BAR; PG8_SCHED;
#if PG8_LATE == 2
            PG8_LDA(At, 1, 1); PG8_STAGE(PG8_SB(1, 0), b3, voffB);
            PG8_WAIT_V(4); PG8_WAIT_L(0); PG8_BAR; PG8_MMA(1, 0, At, B0); PG8_SCHED; PG8_STAGE(PG8_SB(1, 1), b3 + hstepB, voffB); PG8_STAGE(PG8_SA(1, 0), a3, voffA); PG8_SCHED; PG8_MMA(1, 1, At, B1); PG8_BAR; PG8_SCHED;
#elif PG8_LATE == 1
            PG8_LDA(At, 1, 1); PG8_STAGE(PG8_SB(1, 0), b3, voffB); PG8_STAGE(PG8_SB(1, 1), b3 + hstepB, voffB);
            PG8_WAIT_V(6); PG8_WAIT_L(0); PG8_BAR; PG8_MMA(1, 0, At, B0); PG8_SCHED; PG8_STAGE(PG8_SA(1, 0), a3, voffA); PG8_SCHED; PG8_MMA(1, 1, At, B1); PG8_BAR; PG8_SCHED;
#else
            PG8_LDA(At, 1, 1); PG8_STAGE(PG8_SB(1, 0), b3, voffB); PG8_STAGE(PG8_SB(1, 1), b3 + hstepB, voffB); PG8_STAGE(PG8_SA(1, 0), a3, voffA);
            PG8_WAIT_V(8); PG8_WAIT_L(0); PG8_BAR; PG8_MMA(1, 0, At, B0); PG8_MMA(1, 1, At, B1); PG8_BAR; PG8_SCHED;
#endif
            } else {
            PG8_LDB(B0, 0, 0); PG8_SCHED; PG8_LDA(At, 0, 0); PG8_STAGE(PG8_SA(1, 1), a1 + hstep, voffA);
            PG8_WAIT_L(8); PG8_BAR; PG8_WAIT_L(0); PG8_MMA(0, 0, At, B0); PG8_BAR; PG8_SCHED;
            PG8_LDB(B1, 0, 1); PG8_STAGE(PG8_SB(0, 0), b2, voffB);
            PG8_BAR; PG8_WAIT_L(0); PG8_MMA(0, 1, At, B1); PG8_BAR;
            PG8_LDA(At, 0, 1); PG8_STAGE(PG8_SA(0, 0), a2, voffA);
            PG8_BAR; PG8_WAIT_L(0); PG8_MMA(1, 0, At, B0); PG8_BAR; PG8_SCHED;
            PG8_STAGE(PG8_SB(0, 1), b2 + hstepB, voffB);
            PG8_WAIT_V(6); PG8_BAR; PG8_MMA(1, 1, At, B1); PG8_BAR;
            PG8_LDB(B0, 1, 0); PG8_SCHED; PG8_LDA(At, 1, 0); PG8_STAGE(PG8_SA(0, 1), a2 + hstep, voffA);
            PG8_WAIT_L(8); PG8_BAR; PG8_WAIT_L(0); PG8_MMA(0, 0, At, B0); PG8_BAR; PG8_SCHED;
            PG8_LDB(B1, 1, 1); PG8_STAGE(PG8_SB(1, 0), b3, voffB);
            PG8_BAR; PG8_WAIT_L(0); PG8_MMA(0, 1, At, B1); PG8_BAR;
            PG8_LDA(At, 1, 1); PG8_STAGE(PG8_SA(1, 0), a3, voffA);
            PG8_BAR; PG8_WAIT_L(0); PG8_MMA(1, 0, At, B0); PG8_BAR; PG8_SCHED;
            PG8_STAGE(PG8_SB(1, 1), b3 + hstepB, voffB);
            PG8_WAIT_V(6); PG8_BAR; PG8_MMA(1, 1, At, B1); PG8_BAR;
            }
        }
        if constexpr (ALIGN_EPI) { if (wr == 0) PG8_BAR; }
        if constexpr (!Epi::AFTER_DRAIN) { E(acc, cur, wr, wc, fr, fq); S.done(cur); }
        if (!has_next) break;
#pragma unroll
        for (int a = 0; a < 2; ++a)
#pragma unroll
            for (int b = 0; b < 2; ++b)
#pragma unroll
                for (int m = 0; m < 4; ++m)
#pragma unroll
                    for (int n = 0; n < 2; ++n) acc[a][b][m][n] = (f32x4){0.f, 0.f, 0.f, 0.f};
        cur = nxt; cA = nA; cB = nB; ++ui;
        if constexpr (ALIGN_EPI) { if (wr == 1) PG8_BAR; }
    }
    PG8_WAIT_V(0);
    if constexpr (!ALIGN_EPI) { if (wr == 0) PG8_BAR; }
    PG8_BAR;
    if constexpr (Epi::AFTER_DRAIN) { E.fused(acc, cur, wr, wc, fr, fq, lds, wid, lane); S.done(cur); }
#undef PG8_SA
#undef PG8_SB
#undef PG8_STAGE
#undef PG8_LDA
#undef PG8_LDB
#undef PG8_MMA
#undef PG8_WAIT_V
#undef PG8_WAIT_L
#undef PG8_BAR
#undef PG8_SCHED
}
}

#define XB_TMO      128
#define XB_XCNT(j)  (256  + 64 * (j))
#define XB_XSUB(j)  (1280 + 64 * (j))
#define XB_XGEN(j)  (2304 + 64 * (j))
#define XB_TOP      3328
#define XB_TOPGEN   3392
#define XCD_BAR_WORDS 3456
#define XB_SPIN_CAP (1u << 18)

__device__ __forceinline__ unsigned xb_ld(unsigned* p)              { return __hip_atomic_load(p, __ATOMIC_RELAXED, __HIP_MEMORY_SCOPE_AGENT); }
__device__ __forceinline__ unsigned xb_add(unsigned* p, unsigned v) { return __hip_atomic_fetch_add(p, v, __ATOMIC_RELAXED, __HIP_MEMORY_SCOPE_AGENT); }
__device__ __forceinline__ unsigned xb_xcc_id() { return (unsigned)__builtin_amdgcn_s_getreg((3 << 11) | 20) & 0xFu; }
#define XB_SPIN(cond, bar) do { unsigned _sp = 0; while (cond) { __builtin_amdgcn_s_sleep(1); \
    if ((++_sp & 255u) == 0u) { if (xb_ld(&(bar)[XB_TMO])) break; if (_sp > XB_SPIN_CAP) { atomicAdd(&(bar)[XB_TMO], 1u); break; } } } } while (0)

struct XcdBarrier {
    unsigned* bar; unsigned x;
    volatile LAS unsigned* st;
};

__device__ __forceinline__ XcdBarrier xcd_barrier_post(unsigned* bar, volatile LAS unsigned* st) {
    XcdBarrier b; b.bar = bar; b.x = xb_xcc_id(); b.st = st;
    if (threadIdx.x == 0) (void)xb_add(&bar[XB_XCNT(b.x)], 1u);
    return b;
}
__device__ __forceinline__ void xcd_barrier_complete(unsigned* bar, unsigned x, unsigned& nloc, unsigned& nx) {
    const unsigned G = gridDim.x * gridDim.y * gridDim.z;
    unsigned sum, cnt, mine, sp = 0u;
    for (;;) {
        sum = 0u; cnt = 0u; mine = 0u;
#pragma unroll
        for (unsigned j = 0; j < 16; ++j) { const unsigned c = xb_ld(&bar[XB_XCNT(j)]); sum += c; cnt += (c > 0u) ? 1u : 0u; mine = (j == x) ? c : mine; }
        if (sum == G) break;
        __builtin_amdgcn_s_sleep(1);
        if ((++sp & 255u) == 0u) { if (xb_ld(&bar[XB_TMO])) break; if (sp > XB_SPIN_CAP) { atomicAdd(&bar[XB_TMO], 1u); break; } }
    }
    nloc = mine > 0u ? mine : 1u; nx = cnt > 0u ? cnt : 1u;
}

__device__ __forceinline__ void xcd_barrier(const XcdBarrier& b) {
    asm volatile("s_waitcnt vmcnt(0)" ::: "memory");
    __syncthreads();
    if (threadIdx.x == 0) {
        unsigned* bar = b.bar;
        __builtin_amdgcn_s_waitcnt(0);
        unsigned nloc = b.st[0], nx = b.st[1];
        if (nloc == 0u) { xcd_barrier_complete(bar, b.x, nloc, nx); b.st[0] = nloc; b.st[1] = nx; }
        const unsigned old = xb_add(&bar[XB_XSUB(b.x)], 1u);
        const unsigned gen = old / nloc;
        if (old + 1u == (gen + 1u) * nloc) {
            __builtin_amdgcn_fence(__ATOMIC_RELEASE, "agent");
            asm volatile("s_waitcnt vmcnt(0)" ::: "memory");
            const unsigned og = xb_add(&bar[XB_TOP], 1u);
            const unsigned tg = og / nx;
            if (og + 1u == (tg + 1u) * nx) xb_add(&bar[XB_TOPGEN], 1u);
            else XB_SPIN(xb_ld(&bar[XB_TOPGEN]) == tg, bar);
            __builtin_amdgcn_fence(__ATOMIC_ACQUIRE, "agent");
            xb_add(&bar[XB_XGEN(b.x)], 1u);
            asm volatile("s_waitcnt vmcnt(0)" ::: "memory");
        } else {
            XB_SPIN(xb_ld(&bar[XB_XGEN(b.x)]) == gen, bar);
            __builtin_amdgcn_fence(__ATOMIC_ACQUIRE, "agent");
            asm volatile("s_waitcnt vmcnt(0)" ::: "memory");
        }
    }
    __syncthreads();
}

namespace att {
typedef unsigned short bf16_t;
typedef short bf16x8 __attribute__((ext_vector_type(8)));
typedef short s16x4 __attribute__((ext_vector_type(4)));
typedef float f32x16 __attribute__((ext_vector_type(16)));
typedef float f32x4 __attribute__((ext_vector_type(4)));
typedef unsigned u32x4 __attribute__((ext_vector_type(4)));
typedef LAS unsigned char lds_u8;
#define SBAR() __builtin_amdgcn_sched_barrier(0)
__device__ __forceinline__ int kswz128(int row, int colB) { return row * 256 + (colB ^ ((row & 7) << 4)); }
__device__ __forceinline__ int kswz64(int row, int colB) { return row * 128 + (colB ^ ((row & 7) << 4)); }
__device__ __forceinline__ int v_st128(int k, int c) { const int kk = (k & ~0xC) | ((k & 4) << 1) | ((k & 8) >> 1); return ((kk >> 3) * 4 + (c >> 5)) * 512 + ((kk & 7) * 32 + (c & 31)) * 2; }
__device__ __forceinline__ int v_st64(int k, int c) { const int kk = (k & ~0xC) | ((k & 4) << 1) | ((k & 8) >> 1); return ((kk >> 3) * 2 + (c >> 5)) * 512 + ((kk & 7) * 32 + (c & 31)) * 2; }
__device__ __forceinline__ int v_rd_base(int lane) { return ((lane & 3) << 3) | (((lane >> 2) & 3) << 6) | (((lane >> 4) & 1) << 5) | (((lane >> 5) & 1) << 8); }
__device__ __forceinline__ unsigned cvtpk(float lo, float hi) { unsigned r; asm volatile("v_cvt_pk_bf16_f32 %0, %1, %2" : "=v"(r) : "v"(lo), "v"(hi)); return r; }
__device__ __forceinline__ float bf2f(short b) { return __uint_as_float(((unsigned)(unsigned short)b) << 16); }
__device__ __forceinline__ unsigned lds_addr(const lds_u8* p) { return (unsigned)(uintptr_t)p; }

template <int D> __device__ __forceinline__ void qkt(f32x16& p0, f32x16& p1, const lds_u8* Kt, int r32, int hi, const bf16x8* qr) {
    p0 = f32x16{}; p1 = f32x16{};
    if constexpr (D == 128) {
        const lds_u8* kb[4];
#pragma unroll
        for (int dd = 0; dd < 4; ++dd) kb[dd] = Kt + kswz128(r32, (dd * 16 + hi * 8) * 2);
#pragma unroll
        for (int d0 = 0; d0 < 8; ++d0) { const lds_u8* a = kb[d0 & 3] + (d0 >> 2) * 128;
            const bf16x8 b0 = *(const LAS bf16x8*)a, b1 = *(const LAS bf16x8*)(a + 32 * 256);
            p0 = __builtin_amdgcn_mfma_f32_32x32x16_bf16(b0, qr[d0], p0, 0, 0, 0);
            p1 = __builtin_amdgcn_mfma_f32_32x32x16_bf16(b1, qr[d0], p1, 0, 0, 0); }
    } else {
#pragma unroll
        for (int d0 = 0; d0 < 4; ++d0) { const lds_u8* a = Kt + kswz64(r32, (d0 * 16 + hi * 8) * 2);
            const bf16x8 b0 = *(const LAS bf16x8*)a, b1 = *(const LAS bf16x8*)(a + 32 * 128);
            p0 = __builtin_amdgcn_mfma_f32_32x32x16_bf16(b0, qr[d0], p0, 0, 0, 0);
            p1 = __builtin_amdgcn_mfma_f32_32x32x16_bf16(b1, qr[d0], p1, 0, 0, 0); }
    }
}
#define ATT_TRRD(dst, off) asm volatile("ds_read_b64_tr_b16 %0, %1 offset:%2" : "=&v"(dst) : "v"(vb), "i"(off) : "memory")
template <int D> __device__ __forceinline__ void pv_tile(f32x16* o, unsigned vb, bf16x8 pa0, bf16x8 pa1, bf16x8 pa2, bf16x8 pa3) {
    constexpr int KS = (D == 128) ? 4096 : 2048, HS = KS / 2;
#define ATT_PV_D0(d0) do { s16x4 l0, l1, l2, l3, h0, h1, h2, h3; constexpr int b_ = (d0) * 512;                                                   \
        ATT_TRRD(l0, b_); ATT_TRRD(h0, b_ + HS); ATT_TRRD(l1, b_ + KS); ATT_TRRD(h1, b_ + KS + HS); ATT_TRRD(l2, b_ + 2 * KS); ATT_TRRD(h2, b_ + 2 * KS + HS); \
        ATT_TRRD(l3, b_ + 3 * KS); ATT_TRRD(h3, b_ + 3 * KS + HS);                                                                                   \
        asm volatile("s_waitcnt lgkmcnt(0)" ::: "memory"); SBAR();                                                                                  \
        o[d0] = __builtin_amdgcn_mfma_f32_32x32x16_bf16(pa0, (bf16x8){l0[0], l0[1], l0[2], l0[3], h0[0], h0[1], h0[2], h0[3]}, o[d0], 0, 0, 0);   \
        o[d0] = __builtin_amdgcn_mfma_f32_32x32x16_bf16(pa1, (bf16x8){l1[0], l1[1], l1[2], l1[3], h1[0], h1[1], h1[2], h1[3]}, o[d0], 0, 0, 0);   \
        o[d0] = __builtin_amdgcn_mfma_f32_32x32x16_bf16(pa2, (bf16x8){l2[0], l2[1], l2[2], l2[3], h2[0], h2[1], h2[2], h2[3]}, o[d0], 0, 0, 0);   \
        o[d0] = __builtin_amdgcn_mfma_f32_32x32x16_bf16(pa3, (bf16x8){l3[0], l3[1], l3[2], l3[3], h3[0], h3[1], h3[2], h3[3]}, o[d0], 0, 0, 0); } while (0)
    ATT_PV_D0(0); ATT_PV_D0(1);
    if constexpr (D == 128) { ATT_PV_D0(2); ATT_PV_D0(3); }
#undef ATT_PV_D0
}
__device__ __forceinline__ void pack_p(const f32x16& p0, const f32x16& p1, bf16x8& pa0, bf16x8& pa1, bf16x8& pa2, bf16x8& pa3) {
#define ATT_PK4(P, B_, OUT) do { unsigned a0 = cvtpk(P[B_+0], P[B_+1]), a1 = cvtpk(P[B_+2], P[B_+3]);                          \
        unsigned b0 = cvtpk(P[B_+4], P[B_+5]), b1 = cvtpk(P[B_+6], P[B_+7]);                                             \
        auto r0 = __builtin_amdgcn_permlane32_swap(a0, b0, false, false); auto r1 = __builtin_amdgcn_permlane32_swap(a1, b1, false, false); \
        u32x4 w = {r0[0], r1[0], r0[1], r1[1]}; OUT = *reinterpret_cast<bf16x8*>(&w); } while (0)
    ATT_PK4(p0, 0, pa0); ATT_PK4(p0, 8, pa1); ATT_PK4(p1, 0, pa2); ATT_PK4(p1, 8, pa3);
#undef ATT_PK4
}
__device__ __forceinline__ float half_max(float v) { auto rr = __builtin_amdgcn_permlane32_swap(__float_as_uint(v), __float_as_uint(v), false, false); return fmaxf(__uint_as_float(rr[0]), __uint_as_float(rr[1])); }
__device__ __forceinline__ float half_sum(float v) { auto rr = __builtin_amdgcn_permlane32_swap(__float_as_uint(v), __float_as_uint(v), false, false); return __uint_as_float(rr[0]) + __uint_as_float(rr[1]); }
template <int D> __device__ __forceinline__ void store_o(const f32x16* o, bf16_t* O, int ldo, lds_u8* stg, int lane) {
    constexpr int PITCH = 2 * D + 16; const int r32 = lane & 31, hi = lane >> 5;
#pragma unroll
    for (int d0 = 0; d0 < D / 32; ++d0)
#pragma unroll
        for (int r = 0; r < 16; r += 2) { const unsigned w = cvtpk(o[d0][r], o[d0][r + 1]); const int row = (r & 3) + 8 * (r >> 2) + 4 * hi;
            lds_u8* p = stg + row * PITCH + (d0 * 32 + r32) * 2;
            *(LAS unsigned short*)p = (unsigned short)w; *(LAS unsigned short*)(p + PITCH) = (unsigned short)(w >> 16); }
    asm volatile("s_waitcnt lgkmcnt(0)" ::: "memory");
    constexpr int CPR = D / 8;
#pragma unroll
    for (int i = 0; i < 32 * CPR / 64; ++i) { const int ch = lane + 64 * i, row = ch / CPR, cc = ch % CPR;
        const u32x4 v = *(const LAS u32x4*)(stg + row * PITCH + cc * 16);
        *(u32x4*)(O + (size_t)row * ldo + cc * 8) = v; }
}

__device__ __forceinline__ void sb_half(f32x16& z, float& C, float m0) {
    float base = C;
#pragma unroll
    for (int g = 3; g >= 0; --g) {
        float zz[4], sp[4];
#pragma unroll
        for (int j = 0; j < 4; ++j) { zz[j] = fminf(z[4 * g + j], 120.f); sp[j] = __builtin_amdgcn_logf(1.0f + __builtin_amdgcn_exp2f(zz[j])); }
        const float s3 = sp[3], s2 = sp[2] + s3, s1 = sp[1] + s2, s0 = sp[0] + s1;
        auto rr = __builtin_amdgcn_permlane32_swap(__float_as_uint(s0), __float_as_uint(s0), false, false);
        const float lo = __uint_as_float(rr[0]), hv = __uint_as_float(rr[1]);
        const float b = fmaf(m0, hv, base);
        z[4 * g + 3] = __builtin_amdgcn_exp2f(zz[3] - (b + s3)); z[4 * g + 2] = __builtin_amdgcn_exp2f(zz[2] - (b + s2));
        z[4 * g + 1] = __builtin_amdgcn_exp2f(zz[1] - (b + s1)); z[4 * g + 0] = __builtin_amdgcn_exp2f(zz[0] - (b + s0));
        base += lo + hv;
    }
    C = base;
}

__device__ __forceinline__ void sb_unit(lds_u8* lds, volatile LAS int* flags, const bf16_t* __restrict__ P, int ldp, int qc, int kc, int vc, bf16_t* __restrict__ MIX, int b, int h, int qb) {
    const int tid = threadIdx.x, wid = __builtin_amdgcn_readfirstlane(tid >> 6), lane = tid & 63, r32 = lane & 31, hi = lane >> 5;
    const int q0 = qb * 256, rowbase = b * SEQ, qlo = q0 + 32 * wid, qpos = qlo + r32, d0 = q0 / 64, dw = d0 + (wid >> 1);
    const float m0 = hi ? 0.f : 1.f;
    bf16x8 qr[8];
    { const bf16_t* qp = P + (size_t)(rowbase + qpos) * ldp + qc + h * 128 + hi * 8;
#pragma unroll
      for (int d = 0; d < 8; ++d) qr[d] = *(const bf16x8*)(qp + d * 16); }
    f32x16 o[4] = {}; float C = 0.f; bool done = false;
    const int sr = tid >> 4, sc = (tid & 15) * 8;
    const bf16_t* Kg = P + (size_t)rowbase * ldp + kc + h * 128 + sc; const bf16_t* Vg = P + (size_t)rowbase * ldp + vc + h * 128 + sc;
    const int kw = kswz128(sr, sc * 2), vw0 = 16384 + v_st128(sr, sc), vw1 = 16384 + v_st128(32 + sr, sc);
    { bf16x8 kk[4][2], vv[4][2];
#pragma unroll
      for (int t = 0; t < 4; ++t) { const size_t r0 = (size_t)((d0 + t) * 64 + sr) * ldp, r1 = r0 + (size_t)32 * ldp;
          kk[t][0] = *(const bf16x8*)(Kg + r0); kk[t][1] = *(const bf16x8*)(Kg + r1); vv[t][0] = *(const bf16x8*)(Vg + r0); vv[t][1] = *(const bf16x8*)(Vg + r1); }
#pragma unroll
      for (int t = 0; t < 4; ++t) { lds_u8* sl = lds + ((d0 + t) & 3) * 32768;
          *(LAS bf16x8*)(sl + kw) = kk[t][0]; *(LAS bf16x8*)(sl + kw + 32 * 256) = kk[t][1]; *(LAS bf16x8*)(sl + vw0) = vv[t][0]; *(LAS bf16x8*)(sl + vw1) = vv[t][1]; } }
    if (lane == 0) flags[wid] = 0;
    __syncthreads();
    for (int s = 0;; ++s) {
        const int jn = d0 - s - 1;
        bf16x8 k0, k1, v0, v1;
        if (jn >= 0) { const size_t r0 = (size_t)(jn * 64 + sr) * ldp, r1 = r0 + (size_t)32 * ldp;
            k0 = *(const bf16x8*)(Kg + r0); k1 = *(const bf16x8*)(Kg + r1); v0 = *(const bf16x8*)(Vg + r0); v1 = *(const bf16x8*)(Vg + r1); }
        const int j = dw - s;
        if (j >= 0 && !done) {
            const lds_u8* Kt = lds + (j & 3) * 32768;
            f32x16 p0, p1; qkt<128>(p0, p1, Kt, r32, hi, qr);
            if (s == 0) {
                const int lim = qpos - j * 64 - 4 * hi; const float NEG = -__builtin_inff();
#pragma unroll
                for (int r = 0; r < 16; ++r) { const int c = (r & 3) + 8 * (r >> 2); if (c >= lim) p0[r] = NEG; if (c + 32 >= lim) p1[r] = NEG; }
            }
            sb_half(p1, C, m0); sb_half(p0, C, m0);
            bf16x8 pa0, pa1, pa2, pa3; pack_p(p0, p1, pa0, pa1, pa2, pa3);
            pv_tile<128>(o, lds_addr(Kt + 16384) + v_rd_base(lane), pa0, pa1, pa2, pa3);
            done = __all(C > 151.f);
        }
        if ((done || j <= 0) && lane == 0) flags[wid] = 1;
        __syncthreads();
        { int all = 1;
#pragma unroll
          for (int w = 0; w < 8; ++w) all &= flags[w];
          if (all) break; }
        if (jn >= 0) { lds_u8* sl = lds + (jn & 3) * 32768;
            *(LAS bf16x8*)(sl + kw) = k0; *(LAS bf16x8*)(sl + kw + 32 * 256) = k1; *(LAS bf16x8*)(sl + vw0) = v0; *(LAS bf16x8*)(sl + vw1) = v1; }
        __syncthreads();
    }
    store_o<128>(o, MIX + (size_t)(rowbase + qlo) * D_MODEL + h * 128, D_MODEL, lds + wid * 8704, lane);
    __syncthreads();
}

__device__ __forceinline__ void mem_unit(lds_u8* lds, const bf16_t* __restrict__ P, int ldp, int qmc, const bf16_t* __restrict__ KV, const float* __restrict__ gq, const float* __restrict__ gk,
                                         bf16_t* __restrict__ MIX, int b, int mh, int qb) {
    const int tid = threadIdx.x, wid = __builtin_amdgcn_readfirstlane(tid >> 6), lane = tid & 63, r32 = lane & 31, hi = lane >> 5;
    const int row = b * SEQ + qb * 256 + 32 * wid;
    const int sr = tid >> 4, sc = (tid & 15) * 8;
    constexpr float SCL = 0.08838834764831845f * 1.4426950408889634f;
    float gg[8];
#pragma unroll
    for (int j = 0; j < 8; ++j) gg[j] = gq[sc + j] * gk[sc + j] * SCL;
#pragma unroll
    for (int t = 0; t < 4; ++t)
#pragma unroll
        for (int hh = 0; hh < 2; ++hh) { const int key = t * 64 + hh * 32 + sr; const bf16_t* kp = KV + (size_t)(b * MEM_LEN + key) * (2 * MEM_W) + mh * 128 + sc;
            const bf16x8 kr = *(const bf16x8*)kp, vr = *(const bf16x8*)(kp + MEM_W);
            float kf[8], ss = 0.f;
#pragma unroll
            for (int j = 0; j < 8; ++j) { kf[j] = bf2f(kr[j]); ss += kf[j] * kf[j]; }
            ss += __shfl_xor(ss, 1); ss += __shfl_xor(ss, 2); ss += __shfl_xor(ss, 4); ss += __shfl_xor(ss, 8);
            const float rs = __builtin_amdgcn_rsqf(ss * (1.0f / 128.0f) + NORM_EPS);
            u32x4 w; w.x = cvtpk(kf[0] * rs * gg[0], kf[1] * rs * gg[1]); w.y = cvtpk(kf[2] * rs * gg[2], kf[3] * rs * gg[3]);
            w.z = cvtpk(kf[4] * rs * gg[4], kf[5] * rs * gg[5]); w.w = cvtpk(kf[6] * rs * gg[6], kf[7] * rs * gg[7]);
            *(LAS u32x4*)(lds + t * 32768 + kswz128(hh * 32 + sr, sc * 2)) = w;
            *(LAS bf16x8*)(lds + t * 32768 + 16384 + v_st128(hh * 32 + sr, sc)) = vr; }
    bf16x8 qr[8]; float ssq = 0.f;
    { const bf16_t* qp = P + (size_t)(row + r32) * ldp + qmc + mh * 128 + hi * 8;
#pragma unroll
      for (int d0 = 0; d0 < 8; ++d0) { qr[d0] = *(const bf16x8*)(qp + d0 * 16);
#pragma unroll
          for (int j = 0; j < 8; ++j) { const float f = bf2f(qr[d0][j]); ssq += f * f; } } }
    ssq = half_sum(ssq);
    const float rq = __builtin_amdgcn_rsqf(ssq * (1.0f / 128.0f) + NORM_EPS);
    __syncthreads();
    float m = -1e30f, l = 0.f;
#pragma unroll 1
    for (int t = 0; t < 4; ++t) { f32x16 p0, p1; qkt<128>(p0, p1, lds + t * 32768, r32, hi, qr);
        float tm = -1e30f;
#pragma unroll
        for (int r = 0; r < 16; ++r) { p0[r] *= rq; p1[r] *= rq; tm = fmaxf(tm, fmaxf(p0[r], p1[r])); }
        tm = half_max(tm); const float mn = fmaxf(m, tm); float ps = 0.f;
#pragma unroll
        for (int r = 0; r < 16; ++r) ps += __builtin_amdgcn_exp2f(p0[r] - mn) + __builtin_amdgcn_exp2f(p1[r] - mn);
        ps = half_sum(ps); l = l * __builtin_amdgcn_exp2f(m - mn) + ps; m = mn; }
    const float nl = -(m + __builtin_amdgcn_logf(l));
    f32x16 o[4] = {};
#pragma unroll 1
    for (int t = 0; t < 4; ++t) { f32x16 p0, p1; qkt<128>(p0, p1, lds + t * 32768, r32, hi, qr);
#pragma unroll
        for (int r = 0; r < 16; ++r) { p0[r] = __builtin_amdgcn_exp2f(fmaf(p0[r], rq, nl)); p1[r] = __builtin_amdgcn_exp2f(fmaf(p1[r], rq, nl)); }
        bf16x8 pa0, pa1, pa2, pa3; pack_p(p0, p1, pa0, pa1, pa2, pa3);
        pv_tile<128>(o, lds_addr(lds + t * 32768 + 16384) + v_rd_base(lane), pa0, pa1, pa2, pa3); }
    __syncthreads();
    store_o<128>(o, MIX + (size_t)row * D_MODEL + TOK_W + mh * 128, D_MODEL, lds + wid * 8704, lane);
    __syncthreads();
}

__device__ __forceinline__ void swa_unit(lds_u8* lds, const bf16_t* __restrict__ P, int ldp, const float* __restrict__ sinks, bf16_t* __restrict__ MIX, int b, int kvh, int qi) {
    const int tid = threadIdx.x, wid = __builtin_amdgcn_readfirstlane(tid >> 6), lane = tid & 63, r32 = lane & 31, hi = lane >> 5;
    const int q0 = qi * 64, rowbase = b * SEQ, hq = kvh * SWA_GROUP + wid;
    const int sr = tid >> 3, sc = (tid & 7) * 8;
    bf16x8 qra[2][4];
#pragma unroll
    for (int rt = 0; rt < 2; ++rt) { const bf16_t* qp = P + (size_t)(rowbase + q0 + 32 * rt + r32) * ldp + hq * 64 + hi * 8;
#pragma unroll
        for (int d0 = 0; d0 < 4; ++d0) qra[rt][d0] = *(const bf16x8*)(qp + d0 * 16); }
#pragma unroll
    for (int t = 0; t < 3; ++t) { const int kb = q0 - 128 + 64 * t;
        if (kb >= 0) { const bf16_t* kp = P + (size_t)(rowbase + kb + sr) * ldp + TOK_W + kvh * 64 + sc;
            const bf16x8 kr = *(const bf16x8*)kp, vr = *(const bf16x8*)(kp + SWA_KV_HEADS * SWA_HD);
            *(LAS bf16x8*)(lds + t * 16384 + kswz64(sr, sc * 2)) = kr; *(LAS bf16x8*)(lds + t * 16384 + 8192 + v_st64(sr, sc)) = vr; } }
    const float sink2 = sinks[hq] * 1.4426950408889634f;
    __syncthreads();
#pragma unroll
    for (int rt = 0; rt < 2; ++rt) {
        const int qlo = q0 + 32 * rt, qpos = qlo + r32;
        const bf16x8* qr = qra[rt];
        f32x16 p[3][2]; const float NEG = -__builtin_inff();
#pragma unroll
        for (int t = 0; t < 3; ++t) { const int kb = q0 - 128 + 64 * t;
            if (kb >= 0) { qkt<64>(p[t][0], p[t][1], lds + t * 16384, r32, hi, qr);
                const int dq = qpos - kb - 4 * hi;
#pragma unroll
                for (int r = 0; r < 16; ++r) { const int c = (r & 3) + 8 * (r >> 2);
                    if ((unsigned)(dq - c) >= (unsigned)WINDOW) p[t][0][r] = NEG;
                    if ((unsigned)(dq - c - 32) >= (unsigned)WINDOW) p[t][1][r] = NEG; } }
            else {
#pragma unroll
                for (int r = 0; r < 16; ++r) { p[t][0][r] = NEG; p[t][1][r] = NEG; } } }
        float m = sink2;
#pragma unroll
        for (int t = 0; t < 3; ++t)
#pragma unroll
            for (int r = 0; r < 16; ++r) m = fmaxf(m, fmaxf(p[t][0][r], p[t][1][r]));
        m = half_max(m);
        float ps = 0.f;
#pragma unroll
        for (int t = 0; t < 3; ++t)
#pragma unroll
            for (int r = 0; r < 16; ++r) { p[t][0][r] = __builtin_amdgcn_exp2f(p[t][0][r] - m); p[t][1][r] = __builtin_amdgcn_exp2f(p[t][1][r] - m); ps += p[t][0][r] + p[t][1][r]; }
        ps = half_sum(ps);
        const float rl = __builtin_amdgcn_rcpf(ps + __builtin_amdgcn_exp2f(sink2 - m));
        f32x16 o[2] = {};
#pragma unroll
        for (int t = 0; t < 3; ++t) { const int kb = q0 - 128 + 64 * t;
            if (kb >= 0) {
#pragma unroll
                for (int r = 0; r < 16; ++r) { p[t][0][r] *= rl; p[t][1][r] *= rl; }
                bf16x8 pa0, pa1, pa2, pa3; pack_p(p[t][0], p[t][1], pa0, pa1, pa2, pa3);
                pv_tile<64>(o, lds_addr(lds + t * 16384 + 8192) + v_rd_base(lane), pa0, pa1, pa2, pa3); } }
        store_o<64>(o, MIX + (size_t)(rowbase + qlo) * D_MODEL + hq * 64, D_MODEL, lds + 49152 + wid * 4608, lane);
    }
    __syncthreads();
}
#undef ATT_TRRD
#undef SBAR
}

constexpr int NWAVES = 8;
#ifndef MK_SPLIT
#define MK_SPLIT 0
#endif
#ifndef PG8_ALIGN
#define PG8_ALIGN true
#endif
#ifndef PG8_SP2
#define PG8_SP2 true
#endif
#ifndef RES_WGM
#define RES_WGM 4
#endif
#ifndef DOWN_REV
#define DOWN_REV 1
#endif
#ifndef PROBE_GROUP
#define PROBE_GROUP 0
#endif
constexpr int REP_GU = PROBE_GROUP == 1 ? 2 : 1, REP_RS = PROBE_GROUP == 2 ? 2 : 1, REP_P0 = PROBE_GROUP == 3 ? 5 : 1, REP_AT = PROBE_GROUP == 4 ? 5 : 1, REP_PJ = PROBE_GROUP == 6 ? 2 : 1;
constexpr size_t MiB = 1u << 20;
constexpr size_t WS_CTL = 0, CTL_ZERO_BYTES = 1 * MiB;
constexpr size_t SZ_WGU = (size_t)2 * D_FF * D_MODEL * 2, SZ_WD = (size_t)D_MODEL * D_FF * 2;
constexpr int IN1_ROWS = 2560;
constexpr size_t WS_WGU = 1 * MiB;
constexpr size_t WS_WD = WS_WGU + 4 * SZ_WGU;
constexpr size_t WS_WIN0 = WS_WD + 4 * SZ_WD;
constexpr size_t WS_WIN1 = WS_WIN0 + (size_t)SB_IN_W * D_MODEL * 2;
constexpr size_t WS_WOUT = WS_WIN1 + (size_t)IN1_ROWS * D_MODEL * 2;
constexpr size_t WS_WMKV = WS_WOUT + 2 * (size_t)D_MODEL * D_MODEL * 2;
constexpr size_t WS_XB = WS_WMKV + 2 * (size_t)2 * MEM_W * D_MODEL * 2;
constexpr size_t WS_ACT = WS_XB + (size_t)M * D_MODEL * 2;
constexpr size_t WS_MIX = WS_ACT + (size_t)M * D_FF * 2;
constexpr size_t WS_MEMN = WS_MIX + (size_t)M * D_MODEL * 2;
constexpr size_t WS_KVM = WS_MEMN + 2 * (size_t)MROWS * D_MODEL * 2;
constexpr size_t WS_SS = WS_KVM + 2 * (size_t)MROWS * 2 * MEM_W * 2;
constexpr size_t WS_END = WS_SS + (size_t)M * 8 * 4;
static_assert(WS_WGU % 256 == 0 && WS_WD % 256 == 0 && WS_WIN0 % 256 == 0 && WS_WIN1 % 256 == 0 && WS_WOUT % 256 == 0 && WS_WMKV % 256 == 0 && WS_XB % 256 == 0 && WS_SS % 256 == 0 && WS_ACT % 256 == 0 &&
              WS_MIX % 256 == 0 && WS_MEMN % 256 == 0 && WS_KVM % 256 == 0, "ws alignment");
constexpr int CW_BAR = 4096;
constexpr int RING_BYTES = 131072;
constexpr int TAB_OFF = 131072;
constexpr int MISC_OFF = 135168, LDS_BYTES = 147456;
constexpr int NPHASE = 2 + 7 * DEPTH;

typedef unsigned short bf16;
typedef unsigned v4u __attribute__((ext_vector_type(4)));
typedef float f32x4 __attribute__((ext_vector_type(4)));
#define LDS_WAIT() asm volatile("s_waitcnt lgkmcnt(0)" ::: "memory")
__device__ __forceinline__ unsigned f2bf(float f) { unsigned u = __builtin_bit_cast(unsigned, f); return (u + 0x7fffu + ((u >> 16) & 1u)) >> 16; }
__device__ __forceinline__ unsigned pk2(float lo, float hi) { return f2bf(lo) | (f2bf(hi) << 16); }
__device__ __forceinline__ float wave_sum(float v) {
#pragma unroll
    for (int o = 1; o < 64; o <<= 1) v += __shfl_xor(v, o);
    return v;
}

struct Ptrs {
    const float *x_in, *mem, *ffn_g, *w_gate, *w_up, *w_down, *mix_g, *mem_g, *w_mkv, *memq_g, *memk_g, *w_out, *w_in0, *w_in1, *swa_qg, *swa_kg, *sinks;
    const int* pos;
    float* out;
    bf16 *WGU, *WD, *WIN0, *WIN1, *WOUT, *WMKV, *XB, *ACT, *MIX, *MEMN, *KVM;
    float* SS;
};

enum { K_PLAIN = 0, K_GU = 1, K_IN1 = 2 };
__device__ __forceinline__ int map_src(int kind, int n, int& sel) {
    sel = 0;
    if (kind == K_GU) { const int pn = n >> 8, p = n & 255; sel = p >> 7; return 128 * pn + (p & 127); }
    if (kind == K_IN1) { const int pn = n >> 8, p = n & 255, bj = p >> 7, wc = (p >> 5) & 3;
        if (pn < 6) return (4 * pn + wc) * 64 + 32 * bj;
        if (pn == 6) return wc < 3 ? TOK_W + wc * 64 + 32 * bj : -1;
        if (pn == 7) return p < 192 ? TOK_W + 192 + p : -1;
        return TOK_W + 384 + (pn - 8) * 256 + p; }
    return n;
}
struct CvtItem { const float* sp; const float* gp; bf16* dp; int Nsrc, flags; };
__device__ __forceinline__ CvtItem cvt_make(const float* src, const float* src2, const float* gain, int Nsrc, int K, bf16* dst, int kind, int n0, int k0, int lane) {
    int sel; const int sc = map_src(kind, n0 + 32 * (lane >> 3), sel);
    CvtItem I; I.sp = (sel ? src2 : src) + (size_t)k0 * Nsrc + (sc < 0 ? 0 : sc) + 4 * (lane & 7); I.gp = gain ? gain + k0 + 8 * (lane & 1) : I.sp; I.Nsrc = Nsrc; I.flags = (sc < 0 ? 1 : 0) | (gain ? 2 : 0);
    I.dp = dst + (size_t)(n0 >> 8) * 256 * K + (size_t)(k0 >> 6) * (256 * 64) + (size_t)((k0 >> 4) & 3) * 4096 + 8 * lane; return I;
}
#define CVT_LD(dst, ptr) asm volatile("global_load_dwordx4 %0, %1, off nt" : "=v"(dst) : "v"(ptr))
__device__ __forceinline__ void cvt_load(const CvtItem& I, f32x4 (&v)[16], f32x4 (&g)[2]) {
    CVT_LD(g[0], (const f32x4*)I.gp); CVT_LD(g[1], (const f32x4*)(I.gp + 4));
#pragma unroll
    for (int i = 0; i < 16; ++i) CVT_LD(v[i], (const f32x4*)(I.sp + (size_t)i * I.Nsrc));
}
template <int N> __device__ __forceinline__ void cvt_wait(f32x4 (&v)[16], f32x4 (&g)[2]) {
    asm volatile("s_waitcnt vmcnt(%9)" : "+v"(v[0]), "+v"(v[1]), "+v"(v[2]), "+v"(v[3]), "+v"(v[4]), "+v"(v[5]), "+v"(v[6]), "+v"(v[7]), "+v"(g[0]) : "n"(N) : "memory");
    asm volatile("" : "+v"(v[8]), "+v"(v[9]), "+v"(v[10]), "+v"(v[11]), "+v"(v[12]), "+v"(v[13]), "+v"(v[14]), "+v"(v[15]), "+v"(g[1]) :: "memory");
}
__device__ __forceinline__ unsigned cvt_pk(float lo, float hi) { unsigned r; asm volatile("v_cvt_pk_bf16_f32 %0, %1, %2" : "=v"(r) : "v"(lo), "v"(hi)); return r; }
__device__ __forceinline__ void cvt_store(const CvtItem& I, const f32x4 (&v)[16], const f32x4 (&g)[2], LAS float* scr, int lane) {
#pragma unroll
    for (int i = 0; i < 16; ++i) { const f32x4 w = (I.flags & 1) ? (f32x4){0.f, 0.f, 0.f, 0.f} : v[i]; *(LAS f32x4*)(scr + i * 260 + 4 * lane) = w; }
    LDS_WAIT(); asm volatile("" ::: "memory");
    const int h = lane & 1;
    const f32x4 one = {1.f, 1.f, 1.f, 1.f}, ga = (I.flags & 2) ? g[0] : one, gb = (I.flags & 2) ? g[1] : one;
#pragma unroll
    for (int j = 0; j < 8; ++j) { const LAS float* s = scr + (8 * h) * 260 + 32 * j + (lane >> 1);
        v4u o; o.x = cvt_pk(s[0 * 260] * ga[0], s[1 * 260] * ga[1]); o.y = cvt_pk(s[2 * 260] * ga[2], s[3 * 260] * ga[3]);
        o.z = cvt_pk(s[4 * 260] * gb[0], s[5 * 260] * gb[1]); o.w = cvt_pk(s[6 * 260] * gb[2], s[7 * 260] * gb[3]);
        *(v4u*)(I.dp + 512 * j) = o; }
    LDS_WAIT(); asm volatile("" ::: "memory");
}
__device__ __forceinline__ void rms_row_to_bf16(const float* __restrict__ xrow, const float* __restrict__ g, bf16* __restrict__ orow, int lane) {
    const f32x4* xr = (const f32x4*)xrow + lane; const f32x4* gr = (const f32x4*)g + lane;
    f32x4 v[8]; float s = 0.f;
#pragma unroll
    for (int j = 0; j < 8; ++j) { v[j] = xr[64 * j]; s += (v[j].x * v[j].x + v[j].y * v[j].y) + (v[j].z * v[j].z + v[j].w * v[j].w); }
    const float rstd = 1.0f / sqrtf(wave_sum(s) * (1.0f / D_MODEL) + NORM_EPS);
    unsigned long long* o8 = (unsigned long long*)orow + lane;
#pragma unroll
    for (int j = 0; j < 8; ++j) { const f32x4 gv = gr[64 * j];
        o8[64 * j] = (unsigned long long)pk2(v[j].x * rstd * gv.x, v[j].y * rstd * gv.y) | ((unsigned long long)pk2(v[j].z * rstd * gv.z, v[j].w * rstd * gv.w) << 32); }
}
__device__ __forceinline__ void stream_rows_init(const float* __restrict__ x, bf16* __restrict__ XB, float* __restrict__ SS, int gw, int ngw, int lane) {
    int m = gw; if (m >= M) return;
    f32x4 v[8];
#pragma unroll
    for (int j = 0; j < 8; ++j) v[j] = __builtin_nontemporal_load((const f32x4*)(x + (size_t)m * D_MODEL) + lane + 64 * j);
    auto emit = [&](const f32x4 (&w)[8], int row) { float s = 0.f;
#pragma unroll
        for (int j = 0; j < 8; ++j) s += (w[j].x * w[j].x + w[j].y * w[j].y) + (w[j].z * w[j].z + w[j].w * w[j].w);
        s = wave_sum(s);
        unsigned long long* o8 = (unsigned long long*)(XB + (size_t)row * D_MODEL) + lane;
#pragma unroll
        for (int j = 0; j < 8; ++j) o8[64 * j] = (unsigned long long)pk2(w[j].x, w[j].y) | ((unsigned long long)pk2(w[j].z, w[j].w) << 32);
        if (lane < 2) *((f32x4*)(SS + (size_t)row * 8) + lane) = (f32x4){lane == 0 ? s : 0.f, 0.f, 0.f, 0.f}; };
    while (m + ngw < M) { const int nx = m + ngw; f32x4 vn[8];
#pragma unroll
        for (int j = 0; j < 8; ++j) vn[j] = __builtin_nontemporal_load((const f32x4*)(x + (size_t)nx * D_MODEL) + lane + 64 * j);
        emit(v, m); m = nx;
#pragma unroll
        for (int j = 0; j < 8; ++j) v[j] = vn[j]; }
    emit(v, m);
}
template <class Decode> __device__ __forceinline__ void cvt_run(const Decode& decode, int first, int stride, int last, LAS float* scr, int lane) {
    if (first >= last) return;
    auto item = [&](int it, const CvtItem& prev) -> CvtItem { if (it < last) return decode(it); CvtItem d = prev; d.Nsrc = 0; return d; };
    int it = first; CvtItem A = decode(it), B; f32x4 va[16], ga[2], vb[16], gb[2];
    cvt_load(A, va, ga); it += stride; B = item(it, A); cvt_load(B, vb, gb);
    cvt_wait<18>(va, ga); cvt_store(A, va, ga, scr, lane);
    while (it < last) {
        A = item(it + stride, B); cvt_load(A, va, ga);
        cvt_wait<26>(vb, gb); cvt_store(B, vb, gb, scr, lane); it += stride;
        if (it >= last) break;
        B = item(it + stride, A); cvt_load(B, vb, gb);
        cvt_wait<26>(va, ga); cvt_store(A, va, ga, scr, lane); it += stride;
    }
    asm volatile("s_waitcnt vmcnt(0)" ::: "memory");
}
__device__ __forceinline__ void p0a_prologue(const Ptrs& T, LAS unsigned char* lds, int gw, int ngw, int wave, int lane) {
    LAS float* scr = (LAS float*)(lds + wave * 16640);
    constexpr int I_MKV = (2 * MEM_W / 64) * (D_MODEL / 64);
    auto decode = [&](int it) -> CvtItem { const int l = it / I_MKV, r = it - l * I_MKV; constexpr int nb = 2 * MEM_W / 256;
        return cvt_make(T.w_mkv + (size_t)l * D_MODEL * 2 * MEM_W, T.w_mkv, nullptr, 2 * MEM_W, D_MODEL, T.WMKV + (size_t)l * 2 * MEM_W * D_MODEL, K_PLAIN, (r % nb) * 256, (r / nb) * 16, lane); };
    cvt_run(decode, gw, ngw, 2 * I_MKV, scr, lane);
    for (int m = gw; m < MROWS; m += ngw)
        for (int l = 0; l < DEPTH; ++l) rms_row_to_bf16(T.mem + (size_t)m * D_MODEL, T.mem_g + l * D_MODEL, T.MEMN + ((size_t)l * MROWS + m) * D_MODEL, lane);
    stream_rows_init(T.x_in, T.XB, T.SS, gw, ngw, lane);
}
__device__ __forceinline__ void p0b_prologue(const Ptrs& T, LAS unsigned char* lds, int vcu, int G, int wave, int lane) {
    LAS float* scr = (LAS float*)(lds + wave * 16640);
    constexpr int I_GU = (2 * D_FF / 64) * (D_MODEL / 64), I_WD = (D_MODEL / 64) * (D_FF / 64), I_IN0 = (SB_IN_W / 64) * (D_MODEL / 64), I_IN1 = (IN1_ROWS / 64) * (D_MODEL / 64), I_OUT = (D_MODEL / 64) * (D_MODEL / 64);
    constexpr int NITEMS = 4 * I_GU + 4 * I_WD + I_IN0 + I_IN1 + 2 * I_OUT;
    auto decode = [&](int it) -> CvtItem {
        int r = it; const float* src; const float* src2 = nullptr; const float* gain = nullptr; bf16* dst; int Nsrc, K, ndst, kind = K_PLAIN;
        if (r < 4 * I_GU) { const int f = r / I_GU; r -= f * I_GU; src = T.w_gate + (size_t)f * D_MODEL * D_FF; src2 = T.w_up + (size_t)f * D_MODEL * D_FF; gain = T.ffn_g + f * D_MODEL;
            dst = T.WGU + (size_t)f * 2 * D_FF * D_MODEL; Nsrc = D_FF; K = D_MODEL; ndst = 2 * D_FF; kind = K_GU; }
        else if ((r -= 4 * I_GU) < 4 * I_WD) { const int f = r / I_WD; r -= f * I_WD; src = T.w_down + (size_t)f * D_FF * D_MODEL; dst = T.WD + (size_t)f * D_MODEL * D_FF; Nsrc = D_MODEL; K = D_FF; ndst = D_MODEL; }
        else if ((r -= 4 * I_WD) < I_IN0) { src = T.w_in0; gain = T.mix_g; dst = T.WIN0; Nsrc = SB_IN_W; K = D_MODEL; ndst = SB_IN_W; }
        else if ((r -= I_IN0) < I_IN1) { src = T.w_in1; gain = T.mix_g + D_MODEL; dst = T.WIN1; Nsrc = SWA_IN_W; K = D_MODEL; ndst = IN1_ROWS; kind = K_IN1; }
        else { r -= I_IN1; const int l = r / I_OUT; r -= l * I_OUT; src = T.w_out + (size_t)l * D_MODEL * D_MODEL; dst = T.WOUT + (size_t)l * D_MODEL * D_MODEL; Nsrc = D_MODEL; K = D_MODEL; ndst = D_MODEL; }
        const int nb = ndst / 256, n0 = (r % nb) * 256, k0 = (r / nb) * 16;
        return cvt_make(src, src2 ? src2 : src, gain, Nsrc, K, dst, kind, n0, k0, lane); };
    if (G == 256) {
        constexpr int NA = 32 * NWAVES, SHARE_A = 15, SHARE_B = 20, NB = (256 - 32) * NWAVES;
        static_assert(NA * SHARE_A + NB * SHARE_B == NITEMS, "conversion shares");
        const int w = vcu * NWAVES + wave;
        if (vcu < 32) {
#pragma unroll
            for (int l = 0; l < DEPTH; ++l) { pg8::Gemm g{T.MEMN + (size_t)l * MROWS * D_MODEL, T.WMKV + (size_t)l * 2 * MEM_W * D_MODEL, MROWS, 2 * MEM_W, D_MODEL};
                pg8::StaticOrder S; S.init(MROWS, 2 * MEM_W, G, (vcu + G - 16 * l) % G);
                pg8::EpiBf16S E{T.KVM + (size_t)l * MROWS * 2 * MEM_W, 2 * MEM_W, 0, 1.f, nullptr, NORM_EPS, {}};
                pg8::gemm_phase<pg8::EpiBf16S, pg8::StaticOrder, PG8_ALIGN, PG8_SP2>(lds, g, S, E); }
            cvt_run(decode, w, NA, NA * SHARE_A, scr, lane);
        } else cvt_run(decode, NA * SHARE_A + (w - NA), NB, NITEMS, scr, lane);
    } else {
#pragma unroll
        for (int l = 0; l < DEPTH; ++l) { pg8::Gemm g{T.MEMN + (size_t)l * MROWS * D_MODEL, T.WMKV + (size_t)l * 2 * MEM_W * D_MODEL, MROWS, 2 * MEM_W, D_MODEL};
            pg8::StaticOrder S; S.init(MROWS, 2 * MEM_W, G, vcu);
            pg8::EpiBf16S E{T.KVM + (size_t)l * MROWS * 2 * MEM_W, 2 * MEM_W, 0, 1.f, nullptr, NORM_EPS, {}};
            pg8::gemm_phase<pg8::EpiBf16S, pg8::StaticOrder, PG8_ALIGN, PG8_SP2>(lds, g, S, E); }
        cvt_run(decode, vcu * NWAVES + wave, G * NWAVES, NITEMS, scr, lane);
    }
}

struct Args { const void* in[18]; float* out; unsigned char* ws; int ph_lo, ph_hi, li, pad; };
static_assert(sizeof(Args) == 18 * 8 + 8 + 8 + 16, "Args has no padding");
struct Ctx { Ptrs T; LAS unsigned char* lds; volatile LAS unsigned* MISC; XcdBarrier bar; int lo, hi, G, bx, vcu, gw, ngw, lane, wave; };
#define IN(k) (c.lo <= (k) && (k) < c.hi)
#define SEAM(k) do { if (IN(k) && IN((k) + 1)) xcd_barrier(c.bar); } while (0)
#define REPBAR() do { if (!MK_SPLIT) xcd_barrier(c.bar); } while (0)
#define RUN_PHASE(k, nrep, call0, call1) do { if (IN(k)) { call0; if constexpr ((nrep) >= 2) { REPBAR(); call1; } if constexpr ((nrep) >= 3) { REPBAR(); call1; } if constexpr ((nrep) >= 4) { REPBAR(); call1; } if constexpr ((nrep) >= 5) { REPBAR(); call1; } } } while (0)
template <int F> __device__ __forceinline__ void ph_up(const Ctx& c) {
    const Ptrs& T = c.T;
    pg8::Gemm g{T.XB, T.WGU + (size_t)F * 2 * D_FF * D_MODEL, M, 2 * D_FF, D_MODEL}; pg8::StaticOrder S; S.init(M, 2 * D_FF, c.G, c.bx);
    pg8::EpiSwiGLU E{T.ACT, D_FF, T.SS, NORM_EPS, {}};
    pg8::gemm_phase<pg8::EpiSwiGLU, pg8::StaticOrder, PG8_ALIGN, PG8_SP2>(c.lds, g, S, E);
}
template <int F, int R = 0> __device__ __forceinline__ void ph_down(const Ctx& c) {
    const Ptrs& T = c.T; pg8::Gemm g{T.ACT, T.WD + (size_t)F * D_MODEL * D_FF, M, D_MODEL, D_FF}; pg8::StaticOrder S; S.init(M, D_MODEL, c.G, c.bx, RES_WGM, DOWN_REV);
    constexpr bool FINAL = (F == 2 * DEPTH - 1);
    pg8::EpiResidB<FINAL> E{T.XB, T.out, T.SS, (LAS float*)(c.lds + TAB_OFF), D_MODEL, R == 0 ? 0.5f : 0.f};
    pg8::gemm_phase<pg8::EpiResidB<FINAL>, pg8::StaticOrder, true, PG8_SP2>(c.lds, g, S, E);
}
template <int L> __device__ __forceinline__ void ph_inproj(const Ctx& c) {
    const Ptrs& T = c.T;
    if constexpr (L % 2 == 0) { pg8::Gemm g{T.XB, T.WIN0, M, SB_IN_W, D_MODEL}; pg8::StaticOrder S; S.init(M, SB_IN_W, c.G, c.bx);
        pg8::EpiBf16S E{T.ACT, SB_IN_W, TOK_W / 256, 0.08838834764831845f * 1.4426950408889634f, T.SS, NORM_EPS, {}};
        pg8::gemm_phase<pg8::EpiBf16S, pg8::StaticOrder, PG8_ALIGN, PG8_SP2>(c.lds, g, S, E); }
    else { pg8::Gemm g{T.XB, T.WIN1, M, IN1_ROWS, D_MODEL}; pg8::StaticOrder S; S.init(M, IN1_ROWS, c.G, c.bx);
        pg8::EpiProjSWA E{T.ACT, IN1_ROWS, T.swa_qg, T.swa_kg, T.pos, 0.125f * 1.4426950408889634f, NORM_EPS, T.SS};
        pg8::gemm_phase<pg8::EpiProjSWA, pg8::StaticOrder, PG8_ALIGN, PG8_SP2>(c.lds, g, S, E); }
}
#ifndef ATT_LAYER
#define ATT_LAYER -1
#endif
#ifndef ATT_SEL
#define ATT_SEL 0
#endif
template <int L, int R = 0> __device__ __forceinline__ void ph_attn(const Ctx& c) {
    const Ptrs& T = c.T;
    volatile LAS int* flags = (volatile LAS int*)(c.MISC + 16);
    if (R == 0 || ATT_SEL == 0 || ATT_SEL == 1) {
    if constexpr (L % 2 == 0) {
        for (int u = c.vcu; u < BATCH * SB_HEADS * 16; u += c.G) { const int bh = u >> 4, qb = (u + (u >> 8) * 5) & 15;
            att::sb_unit(c.lds, flags, T.ACT, SB_IN_W, 0, TOK_W, 2 * TOK_W, T.MIX, bh / SB_HEADS, bh % SB_HEADS, qb); }
    } else {
        for (int u = c.vcu; u < BATCH * SWA_KV_HEADS * (SEQ / 64); u += c.G) { const int qi = u & 63, bk = u >> 6;
            att::swa_unit(c.lds, T.ACT, IN1_ROWS, T.sinks, T.MIX, bk / SWA_KV_HEADS, bk % SWA_KV_HEADS, qi); }
    } }
    if (R == 0 || ATT_SEL == 0 || ATT_SEL == 2) {
    constexpr int ldp = (L % 2 == 0) ? SB_IN_W : IN1_ROWS, qmc = (L % 2 == 0) ? 3 * TOK_W : TOK_W + 384;
    for (int u = c.vcu; u < BATCH * MEM_HEADS * 16; u += c.G)
        att::mem_unit(c.lds, T.ACT, ldp, qmc, T.KVM + (size_t)L * MROWS * 2 * MEM_W, T.memq_g + L * MEM_HD, T.memk_g + L * MEM_HD, T.MIX, u >> 6, (u >> 4) & 3, u & 15); }
}
template <int L, int R = 0> __device__ __forceinline__ void ph_outproj(const Ctx& c) {
    const Ptrs& T = c.T; pg8::Gemm g{T.MIX, T.WOUT + (size_t)L * D_MODEL * D_MODEL, M, D_MODEL, D_MODEL}; pg8::StaticOrder S; S.init(M, D_MODEL, c.G, c.bx, RES_WGM);
    pg8::EpiResidB<false> E{T.XB, T.out, T.SS, (LAS float*)(c.lds + TAB_OFF), D_MODEL, R == 0 ? 1.0f : 0.f};
    pg8::gemm_phase<pg8::EpiResidB<false>, pg8::StaticOrder, true, PG8_SP2>(c.lds, g, S, E);
}
template <int L> __device__ __forceinline__ void layer_phases(const Ctx& c, int pb) {
    RUN_PHASE(pb + 0, REP_GU, ph_up<2 * L>(c), ph_up<2 * L>(c)); SEAM(pb + 0);
    RUN_PHASE(pb + 1, REP_RS, (ph_down<2 * L, 0>(c)), (ph_down<2 * L, 1>(c))); SEAM(pb + 1);
    RUN_PHASE(pb + 2, REP_PJ, ph_inproj<L>(c), ph_inproj<L>(c)); SEAM(pb + 2);
    RUN_PHASE(pb + 3, (ATT_LAYER < 0 || ATT_LAYER == L ? REP_AT : 1), (ph_attn<L, 0>(c)), (ph_attn<L, 1>(c))); SEAM(pb + 3);
    RUN_PHASE(pb + 4, REP_RS, (ph_outproj<L, 0>(c)), (ph_outproj<L, 1>(c))); SEAM(pb + 4);
    RUN_PHASE(pb + 5, REP_GU, ph_up<2 * L + 1>(c), ph_up<2 * L + 1>(c)); SEAM(pb + 5);
    RUN_PHASE(pb + 6, (2 * L + 1 == 2 * DEPTH - 1 ? 1 : REP_RS), (ph_down<2 * L + 1, 0>(c)), (ph_down<2 * L + 1, 1>(c))); SEAM(pb + 6);
}
__global__ void __launch_bounds__(NWAVES * 64, 2) mk_fwd(Args args) {
    extern __shared__ __attribute__((aligned(16))) unsigned char lds_raw[];
    Ctx c;
    c.lds = (LAS unsigned char*)lds_raw;
    c.MISC = (volatile LAS unsigned*)(c.lds + MISC_OFF);
    const int tid = threadIdx.x;
    c.lane = tid & 63; c.wave = __builtin_amdgcn_readfirstlane(tid >> 6);
    c.G = gridDim.x; c.bx = blockIdx.x;
    const int vcu = (c.G % 8 == 0) ? (c.bx % 8) * (c.G / 8) + c.bx / 8 : c.bx;
    c.vcu = vcu; c.gw = vcu * NWAVES + c.wave; c.ngw = c.G * NWAVES;
    unsigned char* ws = args.ws;
    unsigned* ctl = (unsigned*)(ws + WS_CTL);
    Ptrs& T = c.T;
    T.x_in = (const float*)args.in[0]; T.mem = (const float*)args.in[1]; T.pos = (const int*)args.in[2]; T.ffn_g = (const float*)args.in[3];
    T.w_gate = (const float*)args.in[4]; T.w_up = (const float*)args.in[5]; T.w_down = (const float*)args.in[6]; T.mix_g = (const float*)args.in[7];
    T.mem_g = (const float*)args.in[8]; T.w_mkv = (const float*)args.in[9]; T.memq_g = (const float*)args.in[10]; T.memk_g = (const float*)args.in[11];
    T.w_out = (const float*)args.in[12]; T.w_in0 = (const float*)args.in[13]; T.w_in1 = (const float*)args.in[14]; T.swa_qg = (const float*)args.in[15];
    T.swa_kg = (const float*)args.in[16]; T.sinks = (const float*)args.in[17];
    T.out = args.out;
    T.WGU = (bf16*)(ws + WS_WGU); T.WD = (bf16*)(ws + WS_WD); T.WIN0 = (bf16*)(ws + WS_WIN0); T.WIN1 = (bf16*)(ws + WS_WIN1); T.WOUT = (bf16*)(ws + WS_WOUT); T.WMKV = (bf16*)(ws + WS_WMKV);
    T.XB = (bf16*)(ws + WS_XB); T.ACT = (bf16*)(ws + WS_ACT); T.MIX = (bf16*)(ws + WS_MIX); T.MEMN = (bf16*)(ws + WS_MEMN); T.KVM = (bf16*)(ws + WS_KVM);
    T.SS = (float*)(ws + WS_SS);
    for (int u = tid; u < (LDS_BYTES - MISC_OFF) / 4; u += NWAVES * 64) ((LAS unsigned*)(c.lds + MISC_OFF))[u] = 0u;
    __syncthreads();
    c.bar.bar = ctl + CW_BAR; c.bar.x = 0; c.bar.st = nullptr;
    if (!MK_SPLIT) c.bar = xcd_barrier_post(ctl + CW_BAR, c.MISC + 8);
    c.lo = args.ph_lo; c.hi = args.ph_hi;

    RUN_PHASE(0, 1, p0a_prologue(T, c.lds, c.gw, c.ngw, c.wave, c.lane), p0a_prologue(T, c.lds, c.gw, c.ngw, c.wave, c.lane));
    SEAM(0);
    RUN_PHASE(1, REP_P0, p0b_prologue(T, c.lds, vcu, c.G, c.wave, c.lane), p0b_prologue(T, c.lds, vcu, c.G, c.wave, c.lane));
    SEAM(1);
    layer_phases<0>(c, 2);
    layer_phases<1>(c, 9);
    static_assert(DEPTH == 2 && NPHASE == 16, "phase program written out for two layers");
}
#undef IN
#undef SEAM
#undef RUN_PHASE
#undef REPBAR

extern "C" void kernel_launch(void* const* d_in, const int* in_sizes, int n_in, void* d_out, int out_size, void* d_ws, size_t ws_size, hipStream_t stream) {
    static int grid = 0;
    if (grid == 0) {
        if (n_in != 18 || out_size != M * D_MODEL || ws_size < WS_END) { fprintf(stderr, "kernel_launch: unexpected shapes (n_in %d out %d ws %zu need %zu)\n", n_in, out_size, ws_size, (size_t)WS_END); grid = -1; return; }
        int dev = 0, cus = 0, per_cu = 0;
        if (hipGetDevice(&dev) != hipSuccess || hipDeviceGetAttribute(&cus, hipDeviceAttributeMultiprocessorCount, dev) != hipSuccess) { grid = -1; return; }
        if (hipFuncSetAttribute((const void*)mk_fwd, hipFuncAttributeMaxDynamicSharedMemorySize, LDS_BYTES) != hipSuccess) { fprintf(stderr, "kernel_launch: hipFuncSetAttribute failed\n"); grid = -1; return; }
        if (hipOccupancyMaxActiveBlocksPerMultiprocessor(&per_cu, (const void*)mk_fwd, NWAVES * 64, LDS_BYTES) != hipSuccess || per_cu < 1) fprintf(stderr, "kernel_launch: occupancy query reports %d\n", per_cu);
        (void)hipGetLastError();
        grid = cus;
    }
    if (grid < 0) return;
    if (hipMemsetAsync((char*)d_ws + WS_CTL + (size_t)CW_BAR * 4, 0, (size_t)XCD_BAR_WORDS * 4, stream) != hipSuccess) return;
    Args a; memset(&a, 0, sizeof(a));
    for (int i = 0; i < 18; ++i) a.in[i] = d_in[i];
    a.out = (float*)d_out; a.ws = (unsigned char*)d_ws;
#if MK_SPLIT
    for (int p = 0; p < NPHASE; ++p) { a.ph_lo = p; a.ph_hi = p + 1; a.li = p; hipLaunchKernelGGL(mk_fwd, dim3(grid), dim3(NWAVES * 64), LDS_BYTES, stream, a); }
#else
    a.ph_lo = 0; a.ph_hi = NPHASE; a.li = 0;
    hipLaunchKernelGGL(mk_fwd, dim3(grid), dim3(NWAVES * 64), LDS_BYTES, stream, a);
#endif
}
```

```cpp
#include <hip/hip_runtime.h>
#include <cstdio>
#include <cstdint>
#include <cstring>
#include <type_traits>
constexpr int D_MODEL = 2048, BATCH = 4, SEQ = 4096, DEPTH = 2;
constexpr int M = BATCH * SEQ;
constexpr int MEM_LEN = 256, MEM_HEADS = 4, MEM_HD = 128, MEM_W = 512, TOK_W = 1536;
constexpr int SB_HD = 128, SB_HEADS = 12, SWA_HD = 64, SWA_HEADS = 24, SWA_GROUP = 8, SWA_KV_HEADS = 3, WINDOW = 128;
constexpr int D_FF = 5632;
constexpr int SB_IN_W = 3 * TOK_W + MEM_W;
constexpr int SWA_IN_W = TOK_W + 2 * SWA_KV_HEADS * SWA_HD + MEM_W;
constexpr float NORM_EPS = 1e-6f;
constexpr int MROWS = BATCH * MEM_LEN;
#define LAS __attribute__((address_space(3)))
#ifndef PG8_LATE
#define PG8_LATE 0
#endif
namespace pg8 {
#define PG8_LAS __attribute__((address_space(3)))
typedef unsigned short bf16_t;
typedef short bf16x8 __attribute__((ext_vector_type(8)));
typedef float f32x4 __attribute__((ext_vector_type(4)));
typedef unsigned u32x4 __attribute__((ext_vector_type(4)));
constexpr int BM = 256, BK = 64, HALF = 128, HTB = HALF * BK * 2  , STAGE_BYTES = 8 * HTB, NXCD = 8, WGM = 8;

__host__ __device__ __forceinline__ int lds_byte(int r, int c) { const int st = (r >> 4) * 2 + (c >> 5), rr = r & 15, cc = c & 31, ob = rr * 64 + cc * 2; return st * 1024 + (ob ^ (((ob >> 9) & 1) << 5)); }
__host__ __device__ __forceinline__ void stage_rc(int b, int& R, int& C) { const int st = b / 1024, sb = b % 1024, swz = sb ^ (((sb >> 9) & 1) << 5); R = (st >> 1) * 16 + swz / 64; C = (st & 1) * 32 + (swz % 64) / 2; }
__host__ __device__ __forceinline__ int perm32(int rho) { const int n = rho >> 4, i = rho & 15; return 8 * (i >> 2) + 4 * n + (i & 3); }

struct Unit { int pm, pn; };
struct Gemm { const bf16_t* A; const bf16_t* Bt; int M, N, K; };

struct StaticOrder {
    int nM, nN, nwg, G, c, wgm = WGM, rev = 0;
    __host__ __device__ void init(int M, int N, int G_, int c_, int wgm_ = WGM, int rev_ = 0) { nM = M / BM; nN = N / BM; nwg = nM * nN; G = G_; c = c_; wgm = wgm_; rev = rev_; }
    __host__ __device__ bool next(int i, Unit& u) const {
        const long L = (long)i * G + c; if (L >= nwg) return false;
        int wgid = (int)L; { const int q = nwg / NXCD, r = nwg % NXCD, xcd = wgid % NXCD, off = wgid / NXCD; wgid = (xcd < r ? xcd * (q + 1) : r * (q + 1) + (xcd - r) * q) + off; }
        const int nig = wgm * nN, gid = wgid / nig, fm = gid * wgm, gsz = (nM - fm) < wgm ? (nM - fm) : wgm;
        u.pm = fm + ((wgid % nig) % gsz); u.pn = (wgid % nig) / gsz; if (rev) u.pm = nM - 1 - u.pm; return true;
    }
    __device__ __forceinline__ void a_ready(const Unit&) const {}
    __device__ __forceinline__ void done(const Unit&) const {}
};
__device__ __forceinline__ unsigned cvt_pk_bf16(float lo, float hi) { unsigned r; asm volatile("v_cvt_pk_bf16_f32 %0, %1, %2" : "=v"(r) : "v"(lo), "v"(hi)); return r; }
typedef float f32x2 __attribute__((ext_vector_type(2)));
__device__ __forceinline__ float silu_mul(float g, float u) { return g * u * __builtin_amdgcn_rcpf(1.0f + __builtin_amdgcn_exp2f(-1.4426950408889634f * g)); }
__device__ __forceinline__ float bf_lo(unsigned w) { return __uint_as_float(w << 16); }
__device__ __forceinline__ float bf_hi(unsigned w) { return __uint_as_float(w & 0xffff0000u); }
__device__ __forceinline__ void load_rstd(const float* ss, int row0, float eps, float (&rs)[2][4]) {
#pragma unroll
    for (int ai = 0; ai < 2; ++ai) { f32x4 a[4], b[4];
#pragma unroll
        for (int m = 0; m < 4; ++m) { const float* p = ss + (size_t)(row0 + ai * HALF + m * 16) * 8; a[m] = *(const f32x4*)p; b[m] = *(const f32x4*)(p + 4); }
#pragma unroll
        for (int m = 0; m < 4; ++m) { const f32x4 x = a[m], y = b[m];
            rs[ai][m] = __builtin_amdgcn_rsqf((((x[0] + x[1]) + (x[2] + x[3])) + ((y[0] + y[1]) + (y[2] + y[3]))) * (1.0f / 2048.0f) + eps); } }
}
struct RstdCache { mutable int pm = -1; mutable float rs[2][4];
    __device__ __forceinline__ void get(const float* ss, const Unit& u, int row0, float eps) const { if (u.pm != pm) { load_rstd(ss, row0, eps, rs); pm = u.pm; } } };
struct EpiSwiGLU {
    static constexpr bool PERM = true, AFTER_DRAIN = false; static constexpr int NSTORE = 8;
    bf16_t* O; int ldc; const float* ss; float eps; RstdCache rc;
    static __device__ __forceinline__ f32x2 act2(f32x2 g, f32x2 u, float c, float s) { const f32x2 t = g * c;
        f32x2 e; e.x = __builtin_amdgcn_exp2f(t.x); e.y = __builtin_amdgcn_exp2f(t.y); e = e * s + s;
        f32x2 q; q.x = __builtin_amdgcn_rcpf(e.x); q.y = __builtin_amdgcn_rcpf(e.y); return (g * u) * q; }
    __device__ __forceinline__ void operator()(const f32x4 (&acc)[2][2][4][2], const Unit& u, int wr, int wc, int fr, int fq) const {
        const int row0 = u.pm * BM + wr * 64 + fr, col0 = u.pn * HALF + wc * 32 + 8 * fq;
        rc.get(ss, u, row0, eps); const float (&rs)[2][4] = rc.rs;
#pragma unroll
        for (int ai = 0; ai < 2; ++ai)
#pragma unroll
            for (int m = 0; m < 4; ++m) { bf16_t* rowp = O + (size_t)(row0 + ai * HALF + m * 16) * ldc + col0; const float r = rs[ai][m], cc = r * -1.4426950408889634f, sq = __builtin_amdgcn_rcpf(r * r);
                const f32x4 g0 = acc[ai][0][m][0], g1 = acc[ai][0][m][1], u0 = acc[ai][1][m][0], u1 = acc[ai][1][m][1];
                const f32x2 a = act2((f32x2){g0[0], g0[1]}, (f32x2){u0[0], u0[1]}, cc, sq), b = act2((f32x2){g0[2], g0[3]}, (f32x2){u0[2], u0[3]}, cc, sq);
                const f32x2 c = act2((f32x2){g1[0], g1[1]}, (f32x2){u1[0], u1[1]}, cc, sq), d = act2((f32x2){g1[2], g1[3]}, (f32x2){u1[2], u1[3]}, cc, sq);
                u32x4 w; w.x = cvt_pk_bf16(a.x, a.y); w.y = cvt_pk_bf16(b.x, b.y); w.z = cvt_pk_bf16(c.x, c.y); w.w = cvt_pk_bf16(d.x, d.y);
                *(u32x4*)rowp = w; }
    }
};
template <bool FINAL> struct EpiResidB {
    static constexpr bool PERM = true, AFTER_DRAIN = false; static constexpr int NSTORE = 0;
    bf16_t* XB; float* outf; float* ss; PG8_LAS float* tab; int ldc; float alpha;
    __device__ __forceinline__ void operator()(const f32x4 (&acc)[2][2][4][2], const Unit& u, int wr, int wc, int fr, int fq) const {
        const int row0 = u.pm * BM + wr * 64 + fr, col0 = u.pn * BM + wc * 32 + 8 * fq;
        u32x4 xv[2][4][2];
#pragma unroll
        for (int ai = 0; ai < 2; ++ai)
#pragma unroll
            for (int m = 0; m < 4; ++m)
#pragma unroll
                for (int bj = 0; bj < 2; ++bj) xv[ai][m][bj] = *(const u32x4*)(XB + (size_t)(row0 + ai * HALF + m * 16) * ldc + col0 + bj * HALF);
#pragma unroll
        for (int ai = 0; ai < 2; ++ai)
#pragma unroll
            for (int m = 0; m < 4; ++m) { const size_t off = (size_t)(row0 + ai * HALF + m * 16) * ldc + col0; float s = 0.f;
#pragma unroll
                for (int bj = 0; bj < 2; ++bj) { const u32x4 x = xv[ai][m][bj]; const f32x4 a0 = acc[ai][bj][m][0] * alpha, a1 = acc[ai][bj][m][1] * alpha;
                    const f32x4 v0 = {bf_lo(x.x) + a0[0], bf_hi(x.x) + a0[1], bf_lo(x.y) + a0[2], bf_hi(x.y) + a0[3]};
                    const f32x4 v1 = {bf_lo(x.z) + a1[0], bf_hi(x.z) + a1[1], bf_lo(x.w) + a1[2], bf_hi(x.w) + a1[3]};
                    if constexpr (FINAL) { *(f32x4*)(outf + off + bj * HALF) = v0; *(f32x4*)(outf + off + bj * HALF + 4) = v1; }
                    else { s += ((v0[0] * v0[0] + v0[1] * v0[1]) + (v0[2] * v0[2] + v0[3] * v0[3])) + ((v1[0] * v1[0] + v1[1] * v1[1]) + (v1[2] * v1[2] + v1[3] * v1[3]));
                        u32x4 w; w.x = cvt_pk_bf16(v0[0], v0[1]); w.y = cvt_pk_bf16(v0[2], v0[3]); w.z = cvt_pk_bf16(v1[0], v1[1]); w.w = cvt_pk_bf16(v1[2], v1[3]);
                        *(u32x4*)(XB + off + bj * HALF) = w; } }
                if constexpr (!FINAL) { s += __shfl_xor(s, 16); s += __shfl_xor(s, 32); if (fq == 0) tab[(ai * HALF + wr * 64 + m * 16 + fr) * 4 + wc] = s; } }
        if constexpr (!FINAL) {
            asm volatile("s_waitcnt lgkmcnt(0)" ::: "memory"); __builtin_amdgcn_s_barrier(); asm volatile("" ::: "memory");
            const int t = threadIdx.x;
            if (t < BM) { const f32x4 p = *(const PG8_LAS f32x4*)(tab + t * 4); ss[(size_t)(u.pm * BM + t) * 8 + u.pn] = (p[0] + p[1]) + (p[2] + p[3]); }
        }
    }
};
struct EpiBf16S {
    static constexpr bool PERM = true, AFTER_DRAIN = false; static constexpr int NSTORE = 16;
    bf16_t* O; int ldc; int q_tiles; float qscale; const float* ss; float eps; RstdCache rc;
    __device__ __forceinline__ void operator()(const f32x4 (&acc)[2][2][4][2], const Unit& u, int wr, int wc, int fr, int fq) const {
        const int row0 = u.pm * BM + wr * 64 + fr, col0 = u.pn * BM + wc * 32 + 8 * fq; const float sc = u.pn < q_tiles ? qscale : 1.f;
        if (ss) rc.get(ss, u, row0, eps);
        else if (rc.pm != -2) { rc.pm = -2;
#pragma unroll
            for (int ai = 0; ai < 2; ++ai)
#pragma unroll
                for (int m = 0; m < 4; ++m) rc.rs[ai][m] = 1.f; }
        const float (&rs)[2][4] = rc.rs;
#pragma unroll
        for (int ai = 0; ai < 2; ++ai)
#pragma unroll
            for (int m = 0; m < 4; ++m) { bf16_t* rowp = O + (size_t)(row0 + ai * HALF + m * 16) * ldc + col0; const float r = rs[ai][m] * sc;
#pragma unroll
                for (int bj = 0; bj < 2; ++bj) { const f32x4 v0 = acc[ai][bj][m][0] * r, v1 = acc[ai][bj][m][1] * r;
                    u32x4 w; w.x = cvt_pk_bf16(v0[0], v0[1]); w.y = cvt_pk_bf16(v0[2], v0[3]); w.z = cvt_pk_bf16(v1[0], v1[1]); w.w = cvt_pk_bf16(v1[2], v1[3]);
                    *(u32x4*)(rowp + bj * HALF) = w; } }
    }
};
struct EpiProjSWA {
    static constexpr bool PERM = true, AFTER_DRAIN = false; static constexpr int NSTORE = 0;
    bf16_t* O; int ldc; const float* qg; const float* kg; const int* pos; float qscale; float eps; const float* ss;
    __device__ __forceinline__ void operator()(const f32x4 (&acc)[2][2][4][2], const Unit& u, int wr, int wc, int fr, int fq) const {
        const int pn = u.pn, row0 = u.pm * BM + wr * 64 + fr;
        if (pn == 6 && wc == 3) return;
        const float* g = pn < 6 ? qg : kg; const float sc = pn < 6 ? qscale : 1.f;
        const int colbase = (pn < 6 ? (4 * pn + wc) * 64 : 1536 + wc * 64) + 8 * fq;
        f32x4 gv[2][2];
        if (pn <= 6) {
#pragma unroll
            for (int bj = 0; bj < 2; ++bj)
#pragma unroll
                for (int n = 0; n < 2; ++n) gv[bj][n] = *(const f32x4*)(g + 32 * bj + 8 * fq + 4 * n); }
#pragma unroll
        for (int ai = 0; ai < 2; ++ai) {
            float rs[4]; int pv[4];
            { f32x4 a[4], b[4];
#pragma unroll
              for (int m = 0; m < 4; ++m) { const int r = row0 + ai * HALF + m * 16; const float* p = ss + (size_t)r * 8; a[m] = *(const f32x4*)p; b[m] = *(const f32x4*)(p + 4); pv[m] = pos[r]; }
#pragma unroll
              for (int m = 0; m < 4; ++m) { const f32x4 x = a[m], y = b[m];
                  rs[m] = __builtin_amdgcn_rsqf((((x[0] + x[1]) + (x[2] + x[3])) + ((y[0] + y[1]) + (y[2] + y[3]))) * (1.0f / 2048.0f) + eps); } }
            if (pn <= 6) {
#pragma unroll
                for (int m = 0; m < 4; ++m) { const int r = row0 + ai * HALF + m * 16; const float rr = rs[m], pf = (float)pv[m];
                    float ss2 = 0.f;
#pragma unroll
                    for (int bj = 0; bj < 2; ++bj)
#pragma unroll
                        for (int n = 0; n < 2; ++n) { const f32x4 x = acc[ai][bj][m][n]; ss2 += (x[0] * x[0] + x[1] * x[1]) + (x[2] * x[2] + x[3] * x[3]); }
                    ss2 += __shfl_xor(ss2, 16); ss2 += __shfl_xor(ss2, 32);
                    const float rstd = __builtin_amdgcn_rsqf(ss2 * rr * rr * (1.0f / 64.0f) + eps) * sc * rr;
                    u32x4 w1, w2;
#pragma unroll
                    for (int n = 0; n < 2; ++n) { f32x4 c, s;
#pragma unroll
                        for (int j = 0; j < 4; ++j) { const float fi = __builtin_amdgcn_exp2f(-0.41524101186092029f * (float)(8 * fq + 4 * n + j)) * 0.15915494309189535f;
                            const float t = __builtin_amdgcn_fractf(pf * fi); c[j] = __builtin_amdgcn_cosf(t); s[j] = __builtin_amdgcn_sinf(t); }
                        const f32x4 x1 = acc[ai][0][m][n] * gv[0][n] * rstd, x2 = acc[ai][1][m][n] * gv[1][n] * rstd;
                        const f32x4 o1 = x1 * c - x2 * s, o2 = x2 * c + x1 * s;
                        if (n == 0) { w1.x = cvt_pk_bf16(o1[0], o1[1]); w1.y = cvt_pk_bf16(o1[2], o1[3]); w2.x = cvt_pk_bf16(o2[0], o2[1]); w2.y = cvt_pk_bf16(o2[2], o2[3]); }
                        else        { w1.z = cvt_pk_bf16(o1[0], o1[1]); w1.w = cvt_pk_bf16(o1[2], o1[3]); w2.z = cvt_pk_bf16(o2[0], o2[1]); w2.w = cvt_pk_bf16(o2[2], o2[3]); } }
                    bf16_t* rowp = O + (size_t)r * ldc + colbase;
                    *(u32x4*)rowp = w1; *(u32x4*)(rowp + 32) = w2; }
            } else {
#pragma unroll
                for (int bj = 0; bj < 2; ++bj) { const int p = bj * HALF + wc * 32 + 8 * fq;
                    if (pn == 7 && p >= 192) continue;
                    const int col = pn == 7 ? 1728 + p : 1920 + (pn - 8) * 256 + p;
#pragma unroll
                    for (int m = 0; m < 4; ++m) { const float rr = rs[m]; const f32x4 v0 = acc[ai][bj][m][0] * rr, v1 = acc[ai][bj][m][1] * rr;
                        u32x4 w; w.x = cvt_pk_bf16(v0[0], v0[1]); w.y = cvt_pk_bf16(v0[2], v0[3]); w.z = cvt_pk_bf16(v1[0], v1[1]); w.w = cvt_pk_bf16(v1[2], v1[3]);
                        *(u32x4*)(O + (size_t)(row0 + ai * HALF + m * 16) * ldc + col) = w; } }
            }
        }
    }
};
template <class Epi, class Sched, bool ALIGN_EPI = false, bool SP2 = false>
__device__ __forceinline__ void gemm_phase(PG8_LAS unsigned char* lds, const Gemm g, const Sched& S, const Epi& E) {
    const int tid = threadIdx.x, wid = __builtin_amdgcn_readfirstlane(tid >> 6), lane = tid & 63, wr = wid >> 2, wc = wid & 3, fr = lane & 15, fq = lane >> 4;
    const int K = g.K, nt = K / BK;
    unsigned voffA[2], voffB[2];
#pragma unroll
    for (int i = 0; i < 2; ++i) { int R, C; stage_rc(tid * 16 + i * 8192, R, C); const int Rb = Epi::PERM ? ((R & ~31) + perm32(R & 31)) : R;
        voffA[i] = (unsigned)(R * K + C) * 2u; voffB[i] = (unsigned)(Rb * BK + C) * 2u; }
    const size_t kstep = (size_t)(BK * 2);
    const size_t kstepB = (size_t)BM * BK * 2, hstepB = (size_t)HALF * BK * 2;
    const size_t hstep = (size_t)HALF * K * 2;
    const size_t tstep = 2 * hstep;
    const unsigned ldsw = (unsigned)wid * 1024u;
    const int aoff = lds_byte(wr * 64 + fr, fq * 8), boff = lds_byte(wc * 32 + fr, fq * 8);
#define PG8_SA(b, h) (((b) * 2 + (h)) * HTB)
#define PG8_SB(b, h) ((4 + (b) * 2 + (h)) * HTB)
#define PG8_STAGE(bufoff, gbase, voff) do { _Pragma("unroll") for (int _i = 0; _i < 2; ++_i) \
        __builtin_amdgcn_global_load_lds((const unsigned*)((const char*)(gbase) + (voff)[_i]), (PG8_LAS unsigned*)(lds + (bufoff) + ldsw + _i * 8192), 16, 0, 0); } while (0)
#define PG8_LDA(dst, b, h) do { _Pragma("unroll") for (int m = 0; m < 4; ++m) _Pragma("unroll") for (int k = 0; k < 2; ++k) dst[m][k] = *(const PG8_LAS bf16x8*)(lds + PG8_SA(b, h) + aoff + m * 2048 + k * 1024); } while (0)
#define PG8_LDB(dst, b, h) do { _Pragma("unroll") for (int n = 0; n < 2; ++n) _Pragma("unroll") for (int k = 0; k < 2; ++k) dst[n][k] = *(const PG8_LAS bf16x8*)(lds + PG8_SB(b, h) + boff + n * 2048 + k * 1024); } while (0)
#define PG8_MMA(ai, bj, At, Bt) do { __builtin_amdgcn_s_setprio(1); _Pragma("unroll") for (int m = 0; m < 4; ++m) _Pragma("unroll") for (int n = 0; n < 2; ++n) _Pragma("unroll") for (int k = 0; k < 2; ++k) \
        acc[ai][bj][m][n] = __builtin_amdgcn_mfma_f32_16x16x32_bf16(Bt[n][k], At[m][k], acc[ai][bj][m][n], 0, 0, 0); __builtin_amdgcn_s_setprio(0); } while (0)
#define PG8_WAIT_V(n) asm volatile("s_waitcnt vmcnt(" #n ")" ::: "memory")
#define PG8_WAIT_V8R(relaxed) do { if constexpr (Epi::NSTORE > 0) asm volatile("s_cmp_lg_u32 %0, 0\n\ts_cbranch_scc1 .Lpg8r%=\n\ts_waitcnt vmcnt(8)\n.Lpg8r%=:\n\ts_waitcnt vmcnt(%1)" :: "s"(relaxed), "n"(8 + Epi::NSTORE) : "memory", "scc"); \
        else asm volatile("s_waitcnt vmcnt(8)" ::: "memory"); } while (0)
#define PG8_WAIT_L(n) asm volatile("s_waitcnt lgkmcnt(" #n ")" ::: "memory")
#define PG8_BAR __builtin_amdgcn_s_barrier()
#define PG8_SCHED __builtin_amdgcn_sched_barrier(0)
    Unit cur, nxt; int ui = 0;
    if (!S.next(0, cur)) return;
    f32x4 acc[2][2][4][2];
#pragma unroll
    for (int a = 0; a < 2; ++a)
#pragma unroll
        for (int b = 0; b < 2; ++b)
#pragma unroll
            for (int m = 0; m < 4; ++m)
#pragma unroll
                for (int n = 0; n < 2; ++n) acc[a][b][m][n] = (f32x4){0.f, 0.f, 0.f, 0.f};
    bf16x8 At[4][2], B0[2][2], B1[2][2];
    const char* cA = (const char*)g.A + (size_t)cur.pm * tstep; const char* cB = (const char*)g.Bt + (size_t)cur.pn * tstep;
    S.a_ready(cur);
    if constexpr (SP2) {
        PG8_STAGE(PG8_SB(0, 0), cB, voffB); PG8_STAGE(PG8_SB(0, 1), cB + hstepB, voffB); PG8_STAGE(PG8_SA(0, 0), cA, voffA); PG8_STAGE(PG8_SA(0, 1), cA + hstep, voffA);
        if (wr == 1) PG8_BAR;
        PG8_WAIT_V(2); PG8_BAR;
        PG8_STAGE(PG8_SB(1, 0), cB + kstepB, voffB); PG8_STAGE(PG8_SA(1, 0), cA + kstep, voffA); PG8_STAGE(PG8_SB(1, 1), cB + hstepB + kstepB, voffB);
        PG8_WAIT_V(6); PG8_BAR;
    } else {
        PG8_STAGE(PG8_SB(0, 0), cB, voffB); PG8_STAGE(PG8_SA(0, 0), cA, voffA); PG8_STAGE(PG8_SB(0, 1), cB + hstepB, voffB); PG8_STAGE(PG8_SA(0, 1), cA + hstep, voffA);
        if (wr == 1) PG8_BAR;
        PG8_WAIT_V(4); PG8_BAR;
        PG8_STAGE(PG8_SB(1, 0), cB + kstepB, voffB); PG8_STAGE(PG8_SA(1, 0), cA + kstep, voffA); PG8_STAGE(PG8_SB(1, 1), cB + hstepB + kstepB, voffB);
        PG8_WAIT_V(6); PG8_BAR;
    }
    for (;;) {
        const bool has_next = S.next(ui + 1, nxt);
        const char* nA = has_next ? (const char*)g.A + (size_t)nxt.pm * tstep : cA; const char* nB = has_next ? (const char*)g.Bt + (size_t)nxt.pn * tstep : cB;
        for (int t = 0; t < nt; t += 2) {
            const bool last = (t == nt - 2);
            const char* a1 = cA + (size_t)(t + 1) * kstep;
            const char* a2 = last ? nA : cA + (size_t)(t + 2) * kstep; const char* b2 = last ? nB : cB + (size_t)(t + 2) * kstepB;
            const char* a3 = a2 + kstep; const char* b3 = b2 + kstepB;
            if (last && has_next) S.a_ready(nxt);
            if constexpr (SP2) {
            const int after_epi = __builtin_amdgcn_readfirstlane((t == 0 && ui > 0) ? 1 : 0);
            PG8_LDB(B0, 0, 0); PG8_LDB(B1, 0, 1); PG8_SCHED; PG8_LDA(At, 0, 0); PG8_STAGE(PG8_SA(1, 1), a1 + hstep, voffA);
            PG8_WAIT_V8R(after_epi); PG8_WAIT_L(0); PG8_BAR; PG8_MMA(0, 0, At, B0); PG8_MMA(0, 1, At, B1); PG8_BAR; PG8_SCHED;
#if PG8_LATE == 2
            PG8_LDA(At, 0, 1); PG8_STAGE(PG8_SB(0, 0), b2, voffB);
            PG8_WAIT_V(4); PG8_WAIT_L(0); PG8_BAR; PG8_MMA(1, 0, At, B0); PG8_SCHED; PG8_STAGE(PG8_SB(0, 1), b2 + hstepB, voffB); PG8_STAGE(PG8_SA(0, 0), a2, voffA); PG8_SCHED; PG8_MMA(1, 1, At, B1); PG8_BAR; PG8_SCHED;
#elif PG8_LATE == 1
            PG8_LDA(At, 0, 1); PG8_STAGE(PG8_SB(0, 0), b2, voffB); PG8_STAGE(PG8_SB(0, 1), b2 + hstepB, voffB);
            PG8_WAIT_V(6); PG8_WAIT_L(0); PG8_BAR; PG8_MMA(1, 0, At, B0); PG8_SCHED; PG8_STAGE(PG8_SA(0, 0), a2, voffA); PG8_SCHED; PG8_MMA(1, 1, At, B1); PG8_BAR; PG8_SCHED;
#else
            PG8_LDA(At, 0, 1); PG8_STAGE(PG8_SB(0, 0), b2, voffB); PG8_STAGE(PG8_SB(0, 1), b2 + hstepB, voffB); PG8_STAGE(PG8_SA(0, 0), a2, voffA);
            PG8_WAIT_V8R(after_epi); PG8_WAIT_L(0); PG8_BAR; PG8_MMA(1, 0, At, B0); PG8_MMA(1, 1, At, B1); PG8_BAR; PG8_SCHED;
#endif
            PG8_LDB(B0, 1, 0); PG8_LDB(B1, 1, 1); PG8_SCHED; PG8_LDA(At, 1, 0); PG8_STAGE(PG8_SA(0, 1), a2 + hstep, voffA);
            PG8_WAIT_V(8); PG8_WAIT_L(0); PG8_BAR; PG8_MMA(0, 0, At, B0); PG8_MMA(0, 1, At, B1); PG8_BAR; PG8_SCHED;
#if PG8_LATE == 2
            PG8_LDA(At, 1, 1); PG8_STAGE(PG8_SB(1, 0), b3, voffB);
            PG8_WAIT_V(4); PG8_WAIT_L(0); PG8_BAR; PG8_MMA(1, 0, At, B0); PG8_SCHED; PG8_STAGE(PG8_SB(1, 1), b3 + hstepB, voffB); PG8_STAGE(PG8_SA(1, 0), a3, voffA); PG8_SCHED; PG8_MMA(1, 1, At, B1); PG8_BAR; PG8_SCHED;
#elif PG8_LATE == 1
            PG8_LDA(At, 1, 1); PG8_STAGE(PG8_SB(1, 0), b3, voffB); PG8_STAGE(PG8_SB(1, 1), b3 + hstepB, voffB);
            PG8_WAIT_V(6); PG8_WAIT_L(0); PG8_BAR; PG8_MMA(1, 0, At, B0); PG8_SCHED; PG8_STAGE(PG8_SA(1, 0), a3, voffA); PG8_SCHED; PG8_MMA(1, 1, At, B1); PG8_BAR; PG8_SCHED;
#else
            PG8_LDA(At, 1, 1); PG8_STAGE(PG8_SB(1, 0), b3, voffB); PG8_STAGE(PG8_SB(1, 1), b3 + hstepB, voffB); PG8_STAGE(PG8_SA(1, 0), a3, voffA);
            PG8_WAIT_V(8); PG8_WAIT_L(0); PG8_BAR; PG8_MMA(1, 0, At, B0); PG8_MMA(1, 1, At, B1); PG8_BAR; PG8_SCHED;
#endif
            } else {
            PG8_LDB(B0, 0, 0); PG8_SCHED; PG8_LDA(At, 0, 0); PG8_STAGE(PG8_SA(1, 1), a1 + hstep, voffA);
            PG8_WAIT_L(8); PG8_BAR; PG8_WAIT_L(0); PG8_MMA(0, 0, At, B0); PG8_BAR; PG8_SCHED;
            PG8_LDB(B1, 0, 1); PG8_STAGE(PG8_SB(0, 0), b2, voffB);
            PG8_BAR; PG8_WAIT_L(0); PG8_MMA(0, 1, At, B1); PG8_BAR;
            PG8_LDA(At, 0, 1); PG8_STAGE(PG8_SA(0, 0), a2, voffA);
            PG8_BAR; PG8_WAIT_L(0); PG8_MMA(1, 0, At, B0); PG8_BAR; PG8_SCHED;
            PG8_STAGE(PG8_SB(0, 1), b2 + hstepB, voffB);
            PG8_WAIT_V(6); PG8_BAR; PG8_MMA(1, 1, At, B1); PG8_BAR;
            PG8_LDB(B0, 1, 0); PG8_SCHED; PG8_LDA(At, 1, 0); PG8_STAGE(PG8_SA(0, 1), a2 + hstep, voffA);
            PG8_WAIT_L(8); PG8_BAR; PG8_WAIT_L(0); PG8_MMA(0, 0, At, B0); PG8_BAR; PG8_SCHED;
            PG8_LDB(B1, 1, 1); PG8_STAGE(PG8_SB(1, 0), b3, voffB);
            PG8_BAR; PG8_WAIT_L(0); PG8_MMA(0, 1, At, B1); PG8_BAR;
            PG8_LDA(At, 1, 1); PG8_STAGE(PG8_SA(1, 0), a3, voffA);
            PG8_BAR; PG8_WAIT_L(0); PG8_MMA(1, 0, At, B0); PG8_BAR; PG8_SCHED;
            PG8_STAGE(PG8_SB(1, 1), b3 + hstepB, voffB);
            PG8_WAIT_V(6); PG8_BAR; PG8_MMA(1, 1, At, B1); PG8_BAR;
            }
        }
        if constexpr (ALIGN_EPI) { if (wr == 0) PG8_BAR; }
        if constexpr (!Epi::AFTER_DRAIN) { E(acc, cur, wr, wc, fr, fq); S.done(cur); }
        if (!has_next) break;
#pragma unroll
        for (int a = 0; a < 2; ++a)
#pragma unroll
            for (int b = 0; b < 2; ++b)
#pragma unroll
                for (int m = 0; m < 4; ++m)
#pragma unroll
                    for (int n = 0; n < 2; ++n) acc[a][b][m][n] = (f32x4){0.f, 0.f, 0.f, 0.f};
        cur = nxt; cA = nA; cB = nB; ++ui;
        if constexpr (ALIGN_EPI) { if (wr == 1) PG8_BAR; }
    }
    PG8_WAIT_V(0);
    if constexpr (!ALIGN_EPI) { if (wr == 0) PG8_BAR; }
    PG8_BAR;
    if constexpr (Epi::AFTER_DRAIN) { E.fused(acc, cur, wr, wc, fr, fq, lds, wid, lane); S.done(cur); }
#undef PG8_SA
#undef PG8_SB
#undef PG8_STAGE
#undef PG8_LDA
#undef PG8_LDB
#undef PG8_MMA
#undef PG8_WAIT_V
#undef PG8_WAIT_V8R
#undef PG8_WAIT_L
#undef PG8_BAR
#undef PG8_SCHED
}
}

#define XB_TMO      128
#define XB_XCNT(j)  (256  + 64 * (j))
#define XB_XSUB(j)  (1280 + 64 * (j))
#define XB_XGEN(j)  (2304 + 64 * (j))
#define XB_TOP      3328
#define XB_TOPGEN   3392
#define XCD_BAR_WORDS 3456
#define XB_SPIN_CAP (1u << 18)

__device__ __forceinline__ unsigned xb_ld(unsigned* p)              { return __hip_atomic_load(p, __ATOMIC_RELAXED, __HIP_MEMORY_SCOPE_AGENT); }
__device__ __forceinline__ unsigned xb_add(unsigned* p, unsigned v) { return __hip_atomic_fetch_add(p, v, __ATOMIC_RELAXED, __HIP_MEMORY_SCOPE_AGENT); }
__device__ __forceinline__ unsigned xb_xcc_id() { return (unsigned)__builtin_amdgcn_s_getreg((3 << 11) | 20) & 0xFu; }
#define XB_SPIN(cond, bar) do { unsigned _sp = 0; while (cond) { __builtin_amdgcn_s_sleep(1); \
    if ((++_sp & 255u) == 0u) { if (xb_ld(&(bar)[XB_TMO])) break; if (_sp > XB_SPIN_CAP) { atomicAdd(&(bar)[XB_TMO], 1u); break; } } } } while (0)

struct XcdBarrier {
    unsigned* bar; unsigned x;
    volatile LAS unsigned* st;
};

__device__ __forceinline__ XcdBarrier xcd_barrier_post(unsigned* bar, volatile LAS unsigned* st) {
    XcdBarrier b; b.bar = bar; b.x = xb_xcc_id(); b.st = st;
    if (threadIdx.x == 0) (void)xb_add(&bar[XB_XCNT(b.x)], 1u);
    return b;
}
__device__ __forceinline__ void xcd_barrier_complete(unsigned* bar, unsigned x, unsigned& nloc, unsigned& nx) {
    const unsigned G = gridDim.x * gridDim.y * gridDim.z;
    unsigned sum, cnt, mine, sp = 0u;
    for (;;) {
        sum = 0u; cnt = 0u; mine = 0u;
#pragma unroll
        for (unsigned j = 0; j < 16; ++j) { const unsigned c = xb_ld(&bar[XB_XCNT(j)]); sum += c; cnt += (c > 0u) ? 1u : 0u; mine = (j == x) ? c : mine; }
        if (sum == G) break;
        __builtin_amdgcn_s_sleep(1);
        if ((++sp & 255u) == 0u) { if (xb_ld(&bar[XB_TMO])) break; if (sp > XB_SPIN_CAP) { atomicAdd(&bar[XB_TMO], 1u); break; } }
    }
    nloc = mine > 0u ? mine : 1u; nx = cnt > 0u ? cnt : 1u;
}

__device__ __forceinline__ void xcd_barrier(const XcdBarrier& b) {
    asm volatile("s_waitcnt vmcnt(0)" ::: "memory");
    __syncthreads();
    if (threadIdx.x == 0) {
        unsigned* bar = b.bar;
        __builtin_amdgcn_s_waitcnt(0);
        unsigned nloc = b.st[0], nx = b.st[1];
        if (nloc == 0u) { xcd_barrier_complete(bar, b.x, nloc, nx); b.st[0] = nloc; b.st[1] = nx; }
        const unsigned old = xb_add(&bar[XB_XSUB(b.x)], 1u);
        const unsigned gen = old / nloc;
        if (old + 1u == (gen + 1u) * nloc) {
            __builtin_amdgcn_fence(__ATOMIC_RELEASE, "agent");
            asm volatile("s_waitcnt vmcnt(0)" ::: "memory");
            const unsigned og = xb_add(&bar[XB_TOP], 1u);
            const unsigned tg = og / nx;
            if (og + 1u == (tg + 1u) * nx) xb_add(&bar[XB_TOPGEN], 1u);
            else XB_SPIN(xb_ld(&bar[XB_TOPGEN]) == tg, bar);
            __builtin_amdgcn_fence(__ATOMIC_ACQUIRE, "agent");
            xb_add(&bar[XB_XGEN(b.x)], 1u);
            asm volatile("s_waitcnt vmcnt(0)" ::: "memory");
        } else {
            XB_SPIN(xb_ld(&bar[XB_XGEN(b.x)]) == gen, bar);
            __builtin_amdgcn_fence(__ATOMIC_ACQUIRE, "agent");
            asm volatile("s_waitcnt vmcnt(0)" ::: "memory");
        }
    }
    __syncthreads();
}

namespace att {
typedef unsigned short bf16_t;
typedef short bf16x8 __attribute__((ext_vector_type(8)));
typedef short s16x4 __attribute__((ext_vector_type(4)));
typedef float f32x16 __attribute__((ext_vector_type(16)));
typedef float f32x4 __attribute__((ext_vector_type(4)));
typedef unsigned u32x4 __attribute__((ext_vector_type(4)));
typedef LAS unsigned char lds_u8;
#define SBAR() __builtin_amdgcn_sched_barrier(0)
__device__ __forceinline__ int kswz128(int row, int colB) { return row * 256 + (colB ^ ((row & 7) << 4)); }
__device__ __forceinline__ int kswz64(int row, int colB) { return row * 128 + (colB ^ ((row & 7) << 4)); }
__device__ __forceinline__ int v_st128(int k, int c) { const int kk = (k & ~0xC) | ((k & 4) << 1) | ((k & 8) >> 1); return ((kk >> 3) * 4 + (c >> 5)) * 512 + ((kk & 7) * 32 + (c & 31)) * 2; }
__device__ __forceinline__ int v_st64(int k, int c) { const int kk = (k & ~0xC) | ((k & 4) << 1) | ((k & 8) >> 1); return ((kk >> 3) * 2 + (c >> 5)) * 512 + ((kk & 7) * 32 + (c & 31)) * 2; }
__device__ __forceinline__ int v_rd_base(int lane) { return ((lane & 3) << 3) | (((lane >> 2) & 3) << 6) | (((lane >> 4) & 1) << 5) | (((lane >> 5) & 1) << 8); }
__device__ __forceinline__ unsigned cvtpk(float lo, float hi) { unsigned r; asm volatile("v_cvt_pk_bf16_f32 %0, %1, %2" : "=v"(r) : "v"(lo), "v"(hi)); return r; }
__device__ __forceinline__ float bf2f(short b) { return __uint_as_float(((unsigned)(unsigned short)b) << 16); }
__device__ __forceinline__ unsigned lds_addr(const lds_u8* p) { return (unsigned)(uintptr_t)p; }

template <int D> __device__ __forceinline__ void qkt(f32x16& p0, f32x16& p1, const lds_u8* Kt, int r32, int hi, const bf16x8* qr) {
    p0 = f32x16{}; p1 = f32x16{};
    if constexpr (D == 128) {
        const lds_u8* kb[4];
#pragma unroll
        for (int dd = 0; dd < 4; ++dd) kb[dd] = Kt + kswz128(r32, (dd * 16 + hi * 8) * 2);
#pragma unroll
        for (int d0 = 0; d0 < 8; ++d0) { const lds_u8* a = kb[d0 & 3] + (d0 >> 2) * 128;
            const bf16x8 b0 = *(const LAS bf16x8*)a, b1 = *(const LAS bf16x8*)(a + 32 * 256);
            p0 = __builtin_amdgcn_mfma_f32_32x32x16_bf16(b0, qr[d0], p0, 0, 0, 0);
            p1 = __builtin_amdgcn_mfma_f32_32x32x16_bf16(b1, qr[d0], p1, 0, 0, 0); }
    } else {
#pragma unroll
        for (int d0 = 0; d0 < 4; ++d0) { const lds_u8* a = Kt + kswz64(r32, (d0 * 16 + hi * 8) * 2);
            const bf16x8 b0 = *(const LAS bf16x8*)a, b1 = *(const LAS bf16x8*)(a + 32 * 128);
            p0 = __builtin_amdgcn_mfma_f32_32x32x16_bf16(b0, qr[d0], p0, 0, 0, 0);
            p1 = __builtin_amdgcn_mfma_f32_32x32x16_bf16(b1, qr[d0], p1, 0, 0, 0); }
    }
}
#define ATT_TRRD(dst, off) asm volatile("ds_read_b64_tr_b16 %0, %1 offset:%2" : "=&v"(dst) : "v"(vb), "i"(off) : "memory")
template <int D> __device__ __forceinline__ void pv_tile(f32x16* o, unsigned vb, bf16x8 pa0, bf16x8 pa1, bf16x8 pa2, bf16x8 pa3) {
    constexpr int KS = (D == 128) ? 4096 : 2048, HS = KS / 2;
#define ATT_PV_D0(d0) do { s16x4 l0, l1, l2, l3, h0, h1, h2, h3; constexpr int b_ = (d0) * 512;                                                   \
        ATT_TRRD(l0, b_); ATT_TRRD(h0, b_ + HS); ATT_TRRD(l1, b_ + KS); ATT_TRRD(h1, b_ + KS + HS); ATT_TRRD(l2, b_ + 2 * KS); ATT_TRRD(h2, b_ + 2 * KS + HS); \
        ATT_TRRD(l3, b_ + 3 * KS); ATT_TRRD(h3, b_ + 3 * KS + HS);                                                                                   \
        asm volatile("s_waitcnt lgkmcnt(0)" ::: "memory"); SBAR();                                                                                  \
        o[d0] = __builtin_amdgcn_mfma_f32_32x32x16_bf16(pa0, (bf16x8){l0[0], l0[1], l0[2], l0[3], h0[0], h0[1], h0[2], h0[3]}, o[d0], 0, 0, 0);   \
        o[d0] = __builtin_amdgcn_mfma_f32_32x32x16_bf16(pa1, (bf16x8){l1[0], l1[1], l1[2], l1[3], h1[0], h1[1], h1[2], h1[3]}, o[d0], 0, 0, 0);   \
        o[d0] = __builtin_amdgcn_mfma_f32_32x32x16_bf16(pa2, (bf16x8){l2[0], l2[1], l2[2], l2[3], h2[0], h2[1], h2[2], h2[3]}, o[d0], 0, 0, 0);   \
        o[d0] = __builtin_amdgcn_mfma_f32_32x32x16_bf16(pa3, (bf16x8){l3[0], l3[1], l3[2], l3[3], h3[0], h3[1], h3[2], h3[3]}, o[d0], 0, 0, 0); } while (0)
    ATT_PV_D0(0); ATT_PV_D0(1);
    if constexpr (D == 128) { ATT_PV_D0(2); ATT_PV_D0(3); }
#undef ATT_PV_D0
}
__device__ __forceinline__ void pack_p(const f32x16& p0, const f32x16& p1, bf16x8& pa0, bf16x8& pa1, bf16x8& pa2, bf16x8& pa3) {
#define ATT_PK4(P, B_, OUT) do { unsigned a0 = cvtpk(P[B_+0], P[B_+1]), a1 = cvtpk(P[B_+2], P[B_+3]);                          \
        unsigned b0 = cvtpk(P[B_+4], P[B_+5]), b1 = cvtpk(P[B_+6], P[B_+7]);                                             \
        auto r0 = __builtin_amdgcn_permlane32_swap(a0, b0, false, false); auto r1 = __builtin_amdgcn_permlane32_swap(a1, b1, false, false); \
        u32x4 w = {r0[0], r1[0], r0[1], r1[1]}; OUT = *reinterpret_cast<bf16x8*>(&w); } while (0)
    ATT_PK4(p0, 0, pa0); ATT_PK4(p0, 8, pa1); ATT_PK4(p1, 0, pa2); ATT_PK4(p1, 8, pa3);
#undef ATT_PK4
}
__device__ __forceinline__ float half_max(float v) { auto rr = __builtin_amdgcn_permlane32_swap(__float_as_uint(v), __float_as_uint(v), false, false); return fmaxf(__uint_as_float(rr[0]), __uint_as_float(rr[1])); }
__device__ __forceinline__ float half_sum(float v) { auto rr = __builtin_amdgcn_permlane32_swap(__float_as_uint(v), __float_as_uint(v), false, false); return __uint_as_float(rr[0]) + __uint_as_float(rr[1]); }
template <int D> __device__ __forceinline__ void store_o(const f32x16* o, bf16_t* O, int ldo, lds_u8* stg, int lane) {
    constexpr int PITCH = 2 * D + 16; const int r32 = lane & 31, hi = lane >> 5;
#pragma unroll
    for (int d0 = 0; d0 < D / 32; ++d0)
#pragma unroll
        for (int r = 0; r < 16; r += 2) { const unsigned w = cvtpk(o[d0][r], o[d0][r + 1]); const int row = (r & 3) + 8 * (r >> 2) + 4 * hi;
            lds_u8* p = stg + row * PITCH + (d0 * 32 + r32) * 2;
            *(LAS unsigned short*)p = (unsigned short)w; *(LAS unsigned short*)(p + PITCH) = (unsigned short)(w >> 16); }
    asm volatile("s_waitcnt lgkmcnt(0)" ::: "memory");
    constexpr int CPR = D / 8;
#pragma unroll
    for (int i = 0; i < 32 * CPR / 64; ++i) { const int ch = lane + 64 * i, row = ch / CPR, cc = ch % CPR;
        const u32x4 v = *(const LAS u32x4*)(stg + row * PITCH + cc * 16);
        *(u32x4*)(O + (size_t)row * ldo + cc * 8) = v; }
}

__device__ __forceinline__ void sb_half(f32x16& z, float& C, float m0) {
    float base = C;
#pragma unroll
    for (int g = 3; g >= 0; --g) {
        float zz[4], sp[4];
#pragma unroll
        for (int j = 0; j < 4; ++j) { zz[j] = fminf(z[4 * g + j], 120.f); sp[j] = __builtin_amdgcn_logf(1.0f + __builtin_amdgcn_exp2f(zz[j])); }
        const float s3 = sp[3], s2 = sp[2] + s3, s1 = sp[1] + s2, s0 = sp[0] + s1;
        auto rr = __builtin_amdgcn_permlane32_swap(__float_as_uint(s0), __float_as_uint(s0), false, false);
        const float lo = __uint_as_float(rr[0]), hv = __uint_as_float(rr[1]);
        const float b = fmaf(m0, hv, base);
        z[4 * g + 3] = __builtin_amdgcn_exp2f(zz[3] - (b + s3)); z[4 * g + 2] = __builtin_amdgcn_exp2f(zz[2] - (b + s2));
        z[4 * g + 1] = __builtin_amdgcn_exp2f(zz[1] - (b + s1)); z[4 * g + 0] = __builtin_amdgcn_exp2f(zz[0] - (b + s0));
        base += lo + hv;
    }
    C = base;
}

__device__ __forceinline__ void sb_unit(lds_u8* lds, volatile LAS int* flags, const bf16_t* __restrict__ P, int ldp, int qc, int kc, int vc, bf16_t* __restrict__ MIX, int b, int h, int qb) {
    const int tid = threadIdx.x, wid = __builtin_amdgcn_readfirstlane(tid >> 6), lane = tid & 63, r32 = lane & 31, hi = lane >> 5;
    const int q0 = qb * 256, rowbase = b * SEQ, qlo = q0 + 32 * wid, qpos = qlo + r32, d0 = q0 / 64, dw = d0 + (wid >> 1);
    const float m0 = hi ? 0.f : 1.f;
    bf16x8 qr[8];
    { const bf16_t* qp = P + (size_t)(rowbase + qpos) * ldp + qc + h * 128 + hi * 8;
#pragma unroll
      for (int d = 0; d < 8; ++d) qr[d] = *(const bf16x8*)(qp + d * 16); }
    f32x16 o[4] = {}; float C = 0.f; bool done = false;
    const int sr = tid >> 4, sc = (tid & 15) * 8;
    const bf16_t* Kg = P + (size_t)rowbase * ldp + kc + h * 128 + sc; const bf16_t* Vg = P + (size_t)rowbase * ldp + vc + h * 128 + sc;
    const int kw = kswz128(sr, sc * 2), vw0 = 16384 + v_st128(sr, sc), vw1 = 16384 + v_st128(32 + sr, sc);
    { bf16x8 kk[4][2], vv[4][2];
#pragma unroll
      for (int t = 0; t < 4; ++t) { const size_t r0 = (size_t)((d0 + t) * 64 + sr) * ldp, r1 = r0 + (size_t)32 * ldp;
          kk[t][0] = *(const bf16x8*)(Kg + r0); kk[t][1] = *(const bf16x8*)(Kg + r1); vv[t][0] = *(const bf16x8*)(Vg + r0); vv[t][1] = *(const bf16x8*)(Vg + r1); }
#pragma unroll
      for (int t = 0; t < 4; ++t) { lds_u8* sl = lds + ((d0 + t) & 3) * 32768;
          *(LAS bf16x8*)(sl + kw) = kk[t][0]; *(LAS bf16x8*)(sl + kw + 32 * 256) = kk[t][1]; *(LAS bf16x8*)(sl + vw0) = vv[t][0]; *(LAS bf16x8*)(sl + vw1) = vv[t][1]; } }
    if (lane == 0) flags[wid] = 0;
    __syncthreads();
    for (int s = 0;; ++s) {
        const int jn = d0 - s - 1;
        bf16x8 k0, k1, v0, v1;
        if (jn >= 0) { const size_t r0 = (size_t)(jn * 64 + sr) * ldp, r1 = r0 + (size_t)32 * ldp;
            k0 = *(const bf16x8*)(Kg + r0); k1 = *(const bf16x8*)(Kg + r1); v0 = *(const bf16x8*)(Vg + r0); v1 = *(const bf16x8*)(Vg + r1); }
        const int j = dw - s;
        if (j >= 0 && !done) {
            const lds_u8* Kt = lds + (j & 3) * 32768;
            f32x16 p0, p1; qkt<128>(p0, p1, Kt, r32, hi, qr);
            if (s == 0) {
                const int lim = qpos - j * 64 - 4 * hi; const float NEG = -__builtin_inff();
#pragma unroll
                for (int r = 0; r < 16; ++r) { const int c = (r & 3) + 8 * (r >> 2); if (c >= lim) p0[r] = NEG; if (c + 32 >= lim) p1[r] = NEG; }
            }
            sb_half(p1, C, m0); sb_half(p0, C, m0);
            bf16x8 pa0, pa1, pa2, pa3; pack_p(p0, p1, pa0, pa1, pa2, pa3);
            pv_tile<128>(o, lds_addr(Kt + 16384) + v_rd_base(lane), pa0, pa1, pa2, pa3);
            done = __all(C > 151.f);
        }
        if ((done || j <= 0) && lane == 0) flags[wid] = 1;
        __syncthreads();
        { int all = 1;
#pragma unroll
          for (int w = 0; w < 8; ++w) all &= flags[w];
          if (all) break; }
        if (jn >= 0) { lds_u8* sl = lds + (jn & 3) * 32768;
            *(LAS bf16x8*)(sl + kw) = k0; *(LAS bf16x8*)(sl + kw + 32 * 256) = k1; *(LAS bf16x8*)(sl + vw0) = v0; *(LAS bf16x8*)(sl + vw1) = v1; }
        __syncthreads();
    }
    store_o<128>(o, MIX + (size_t)(rowbase + qlo) * D_MODEL + h * 128, D_MODEL, lds + wid * 8704, lane);
    __syncthreads();
}

__device__ __forceinline__ void mem_unit(lds_u8* lds, const bf16_t* __restrict__ P, int ldp, int qmc, const bf16_t* __restrict__ KV, const float* __restrict__ gq, const float* __restrict__ gk,
                                         bf16_t* __restrict__ MIX, int b, int mh, int qb) {
    const int tid = threadIdx.x, wid = __builtin_amdgcn_readfirstlane(tid >> 6), lane = tid & 63, r32 = lane & 31, hi = lane >> 5;
    const int row = b * SEQ + qb * 256 + 32 * wid;
    const int sr = tid >> 4, sc = (tid & 15) * 8;
    constexpr float SCL = 0.08838834764831845f * 1.4426950408889634f;
    float gg[8];
#pragma unroll
    for (int j = 0; j < 8; ++j) gg[j] = gq[sc + j] * gk[sc + j] * SCL;
#pragma unroll
    for (int t = 0; t < 4; ++t)
#pragma unroll
        for (int hh = 0; hh < 2; ++hh) { const int key = t * 64 + hh * 32 + sr; const bf16_t* kp = KV + (size_t)(b * MEM_LEN + key) * (2 * MEM_W) + mh * 128 + sc;
            const bf16x8 kr = *(const bf16x8*)kp, vr = *(const bf16x8*)(kp + MEM_W);
            float kf[8], ss = 0.f;
#pragma unroll
            for (int j = 0; j < 8; ++j) { kf[j] = bf2f(kr[j]); ss += kf[j] * kf[j]; }
            ss += __shfl_xor(ss, 1); ss += __shfl_xor(ss, 2); ss += __shfl_xor(ss, 4); ss += __shfl_xor(ss, 8);
            const float rs = __builtin_amdgcn_rsqf(ss * (1.0f / 128.0f) + NORM_EPS);
            u32x4 w; w.x = cvtpk(kf[0] * rs * gg[0], kf[1] * rs * gg[1]); w.y = cvtpk(kf[2] * rs * gg[2], kf[3] * rs * gg[3]);
            w.z = cvtpk(kf[4] * rs * gg[4], kf[5] * rs * gg[5]); w.w = cvtpk(kf[6] * rs * gg[6], kf[7] * rs * gg[7]);
            *(LAS u32x4*)(lds + t * 32768 + kswz128(hh * 32 + sr, sc * 2)) = w;
            *(LAS bf16x8*)(lds + t * 32768 + 16384 + v_st128(hh * 32 + sr, sc)) = vr; }
    bf16x8 qr[8]; float ssq = 0.f;
    { const bf16_t* qp = P + (size_t)(row + r32) * ldp + qmc + mh * 128 + hi * 8;
#pragma unroll
      for (int d0 = 0; d0 < 8; ++d0) { qr[d0] = *(const bf16x8*)(qp + d0 * 16);
#pragma unroll
          for (int j = 0; j < 8; ++j) { const float f = bf2f(qr[d0][j]); ssq += f * f; } } }
    ssq = half_sum(ssq);
    const float rq = __builtin_amdgcn_rsqf(ssq * (1.0f / 128.0f) + NORM_EPS);
    __syncthreads();
    float m = -1e30f, l = 0.f;
#pragma unroll 1
    for (int t = 0; t < 4; ++t) { f32x16 p0, p1; qkt<128>(p0, p1, lds + t * 32768, r32, hi, qr);
        float tm = -1e30f;
#pragma unroll
        for (int r = 0; r < 16; ++r) { p0[r] *= rq; p1[r] *= rq; tm = fmaxf(tm, fmaxf(p0[r], p1[r])); }
        tm = half_max(tm); const float mn = fmaxf(m, tm); float ps = 0.f;
#pragma unroll
        for (int r = 0; r < 16; ++r) ps += __builtin_amdgcn_exp2f(p0[r] - mn) + __builtin_amdgcn_exp2f(p1[r] - mn);
        ps = half_sum(ps); l = l * __builtin_amdgcn_exp2f(m - mn) + ps; m = mn; }
    const float nl = -(m + __builtin_amdgcn_logf(l));
    f32x16 o[4] = {};
#pragma unroll 1
    for (int t = 0; t < 4; ++t) { f32x16 p0, p1; qkt<128>(p0, p1, lds + t * 32768, r32, hi, qr);
#pragma unroll
        for (int r = 0; r < 16; ++r) { p0[r] = __builtin_amdgcn_exp2f(fmaf(p0[r], rq, nl)); p1[r] = __builtin_amdgcn_exp2f(fmaf(p1[r], rq, nl)); }
        bf16x8 pa0, pa1, pa2, pa3; pack_p(p0, p1, pa0, pa1, pa2, pa3);
        pv_tile<128>(o, lds_addr(lds + t * 32768 + 16384) + v_rd_base(lane), pa0, pa1, pa2, pa3); }
    __syncthreads();
    store_o<128>(o, MIX + (size_t)row * D_MODEL + TOK_W + mh * 128, D_MODEL, lds + wid * 8704, lane);
    __syncthreads();
}

__device__ __forceinline__ void swa_unit(lds_u8* lds, const bf16_t* __restrict__ P, int ldp, const float* __restrict__ sinks, bf16_t* __restrict__ MIX, int b, int kvh, int qi) {
    const int tid = threadIdx.x, wid = __builtin_amdgcn_readfirstlane(tid >> 6), lane = tid & 63, r32 = lane & 31, hi = lane >> 5;
    const int q0 = qi * 64, rowbase = b * SEQ, hq = kvh * SWA_GROUP + wid;
    const int sr = tid >> 3, sc = (tid & 7) * 8;
    bf16x8 qra[2][4];
#pragma unroll
    for (int rt = 0; rt < 2; ++rt) { const bf16_t* qp = P + (size_t)(rowbase + q0 + 32 * rt + r32) * ldp + hq * 64 + hi * 8;
#pragma unroll
        for (int d0 = 0; d0 < 4; ++d0) qra[rt][d0] = *(const bf16x8*)(qp + d0 * 16); }
#pragma unroll
    for (int t = 0; t < 3; ++t) { const int kb = q0 - 128 + 64 * t;
        if (kb >= 0) { const bf16_t* kp = P + (size_t)(rowbase + kb + sr) * ldp + TOK_W + kvh * 64 + sc;
            const bf16x8 kr = *(const bf16x8*)kp, vr = *(const bf16x8*)(kp + SWA_KV_HEADS * SWA_HD);
            *(LAS bf16x8*)(lds + t * 16384 + kswz64(sr, sc * 2)) = kr; *(LAS bf16x8*)(lds + t * 16384 + 8192 + v_st64(sr, sc)) = vr; } }
    const float sink2 = sinks[hq] * 1.4426950408889634f;
    __syncthreads();
#pragma unroll
    for (int rt = 0; rt < 2; ++rt) {
        const int qlo = q0 + 32 * rt, qpos = qlo + r32;
        const bf16x8* qr = qra[rt];
        f32x16 p[3][2]; const float NEG = -__builtin_inff();
#pragma unroll
        for (int t = 0; t < 3; ++t) { const int kb = q0 - 128 + 64 * t;
            if (kb >= 0) { qkt<64>(p[t][0], p[t][1], lds + t * 16384, r32, hi, qr);
                const int dq = qpos - kb - 4 * hi;
#pragma unroll
                for (int r = 0; r < 16; ++r) { const int c = (r & 3) + 8 * (r >> 2);
                    if ((unsigned)(dq - c) >= (unsigned)WINDOW) p[t][0][r] = NEG;
                    if ((unsigned)(dq - c - 32) >= (unsigned)WINDOW) p[t][1][r] = NEG; } }
            else {
#pragma unroll
                for (int r = 0; r < 16; ++r) { p[t][0][r] = NEG; p[t][1][r] = NEG; } } }
        float m = sink2;
#pragma unroll
        for (int t = 0; t < 3; ++t)
#pragma unroll
            for (int r = 0; r < 16; ++r) m = fmaxf(m, fmaxf(p[t][0][r], p[t][1][r]));
        m = half_max(m);
        float ps = 0.f;
#pragma unroll
        for (int t = 0; t < 3; ++t)
#pragma unroll
            for (int r = 0; r < 16; ++r) { p[t][0][r] = __builtin_amdgcn_exp2f(p[t][0][r] - m); p[t][1][r] = __builtin_amdgcn_exp2f(p[t][1][r] - m); ps += p[t][0][r] + p[t][1][r]; }
        ps = half_sum(ps);
        const float rl = __builtin_amdgcn_rcpf(ps + __builtin_amdgcn_exp2f(sink2 - m));
        f32x16 o[2] = {};
#pragma unroll
        for (int t = 0; t < 3; ++t) { const int kb = q0 - 128 + 64 * t;
            if (kb >= 0) {
#pragma unroll
                for (int r = 0; r < 16; ++r) { p[t][0][r] *= rl; p[t][1][r] *= rl; }
                bf16x8 pa0, pa1, pa2, pa3; pack_p(p[t][0], p[t][1], pa0, pa1, pa2, pa3);
                pv_tile<64>(o, lds_addr(lds + t * 16384 + 8192) + v_rd_base(lane), pa0, pa1, pa2, pa3); } }
        store_o<64>(o, MIX + (size_t)(rowbase + qlo) * D_MODEL + hq * 64, D_MODEL, lds + 49152 + wid * 4608, lane);
    }
    __syncthreads();
}
#undef ATT_TRRD
#undef SBAR
}

constexpr int NWAVES = 8;
#ifndef MK_SPLIT
#define MK_SPLIT 0
#endif
#ifndef PG8_ALIGN
#define PG8_ALIGN true
#endif
#ifndef PG8_SP2
#define PG8_SP2 true
#endif
#ifndef RES_WGM
#define RES_WGM 4
#endif
#ifndef DOWN_REV
#define DOWN_REV 1
#endif
#ifndef PROBE_GROUP
#define PROBE_GROUP 0
#endif
constexpr int REP_GU = PROBE_GROUP == 1 ? 2 : 1, REP_RS = PROBE_GROUP == 2 ? 2 : 1, REP_P0 = PROBE_GROUP == 3 ? 5 : 1, REP_AT = PROBE_GROUP == 4 ? 5 : 1, REP_PJ = PROBE_GROUP == 6 ? 2 : 1;
constexpr size_t MiB = 1u << 20;
constexpr size_t WS_CTL = 0, CTL_ZERO_BYTES = 1 * MiB;
constexpr size_t SZ_WGU = (size_t)2 * D_FF * D_MODEL * 2, SZ_WD = (size_t)D_MODEL * D_FF * 2;
constexpr int IN1_ROWS = 2560;
constexpr size_t WS_WGU = 1 * MiB;
constexpr size_t WS_WD = WS_WGU + 4 * SZ_WGU;
constexpr size_t WS_WIN0 = WS_WD + 4 * SZ_WD;
constexpr size_t WS_WIN1 = WS_WIN0 + (size_t)SB_IN_W * D_MODEL * 2;
constexpr size_t WS_WOUT = WS_WIN1 + (size_t)IN1_ROWS * D_MODEL * 2;
constexpr size_t WS_WMKV = WS_WOUT + 2 * (size_t)D_MODEL * D_MODEL * 2;
constexpr size_t WS_XB = WS_WMKV + 2 * (size_t)2 * MEM_W * D_MODEL * 2;
constexpr size_t WS_ACT = WS_XB + (size_t)M * D_MODEL * 2;
constexpr size_t WS_MIX = WS_ACT + (size_t)M * D_FF * 2;
constexpr size_t WS_MEMN = WS_MIX + (size_t)M * D_MODEL * 2;
constexpr size_t WS_KVM = WS_MEMN + 2 * (size_t)MROWS * D_MODEL * 2;
constexpr size_t WS_SS = WS_KVM + 2 * (size_t)MROWS * 2 * MEM_W * 2;
constexpr size_t WS_END = WS_SS + (size_t)M * 8 * 4;
static_assert(WS_WGU % 256 == 0 && WS_WD % 256 == 0 && WS_WIN0 % 256 == 0 && WS_WIN1 % 256 == 0 && WS_WOUT % 256 == 0 && WS_WMKV % 256 == 0 && WS_XB % 256 == 0 && WS_SS % 256 == 0 && WS_ACT % 256 == 0 &&
              WS_MIX % 256 == 0 && WS_MEMN % 256 == 0 && WS_KVM % 256 == 0, "ws alignment");
constexpr int CW_BAR = 4096;
constexpr int RING_BYTES = 131072;
constexpr int TAB_OFF = 131072;
constexpr int MISC_OFF = 135168, LDS_BYTES = 147456;
constexpr int NPHASE = 2 + 7 * DEPTH;

typedef unsigned short bf16;
typedef unsigned v4u __attribute__((ext_vector_type(4)));
typedef float f32x4 __attribute__((ext_vector_type(4)));
#define LDS_WAIT() asm volatile("s_waitcnt lgkmcnt(0)" ::: "memory")
__device__ __forceinline__ unsigned f2bf(float f) { unsigned u = __builtin_bit_cast(unsigned, f); return (u + 0x7fffu + ((u >> 16) & 1u)) >> 16; }
__device__ __forceinline__ unsigned pk2(float lo, float hi) { return f2bf(lo) | (f2bf(hi) << 16); }
__device__ __forceinline__ float wave_sum(float v) {
#pragma unroll
    for (int o = 1; o < 64; o <<= 1) v += __shfl_xor(v, o);
    return v;
}

struct Ptrs {
    const float *x_in, *mem, *ffn_g, *w_gate, *w_up, *w_down, *mix_g, *mem_g, *w_mkv, *memq_g, *memk_g, *w_out, *w_in0, *w_in1, *swa_qg, *swa_kg, *sinks;
    const int* pos;
    float* out;
    bf16 *WGU, *WD, *WIN0, *WIN1, *WOUT, *WMKV, *XB, *ACT, *MIX, *MEMN, *KVM;
    float* SS;
};

enum { K_PLAIN = 0, K_GU = 1, K_IN1 = 2 };
__device__ __forceinline__ int map_src(int kind, int n, int& sel) {
    sel = 0;
    if (kind == K_GU) { const int pn = n >> 8, p = n & 255; sel = p >> 7; return 128 * pn + (p & 127); }
    if (kind == K_IN1) { const int pn = n >> 8, p = n & 255, bj = p >> 7, wc = (p >> 5) & 3;
        if (pn < 6) return (4 * pn + wc) * 64 + 32 * bj;
        if (pn == 6) return wc < 3 ? TOK_W + wc * 64 + 32 * bj : -1;
        if (pn == 7) return p < 192 ? TOK_W + 192 + p : -1;
        return TOK_W + 384 + (pn - 8) * 256 + p; }
    return n;
}
struct CvtItem { const float* sp; const float* gp; bf16* dp; int Nsrc, flags; };
__device__ __forceinline__ CvtItem cvt_make(const float* src, const float* src2, const float* gain, int Nsrc, int K, bf16* dst, int kind, int n0, int k0, int lane) {
    const int f = lane & 15, hf = f >> 3, c4 = (f & 7) * 4; int sel; const int sc = map_src(kind, n0 + 32 * hf, sel);
    CvtItem I; I.sp = (sel ? src2 : src) + (size_t)(k0 + (lane >> 4)) * Nsrc + (sc < 0 ? 0 : sc) + c4; I.gp = gain ? gain + k0 + 8 * (lane & 7) : I.sp; I.Nsrc = Nsrc; I.flags = (sc < 0 ? 1 : 0) | (gain ? 2 : 0);
    I.dp = dst + (size_t)(n0 >> 8) * 256 * K + (size_t)(k0 >> 6) * (256 * 64) + ((n0 & 255) + (lane >> 3)) * 64 + 8 * (lane & 7); return I;
}
#define CVT_LD(dst, ptr) asm volatile("global_load_dwordx4 %0, %1, off nt" : "=v"(dst) : "v"(ptr))
__device__ __forceinline__ void cvt_load(const CvtItem& I, f32x4 (&v)[16], f32x4 (&g)[2]) {
    CVT_LD(g[0], (const f32x4*)I.gp); CVT_LD(g[1], (const f32x4*)(I.gp + 4));
#pragma unroll
    for (int i = 0; i < 16; ++i) CVT_LD(v[i], (const f32x4*)(I.sp + (size_t)(4 * i) * I.Nsrc));
}
template <int N> __device__ __forceinline__ void cvt_wait(f32x4 (&v)[16], f32x4 (&g)[2]) {
    asm volatile("s_waitcnt vmcnt(%9)" : "+v"(v[0]), "+v"(v[1]), "+v"(v[2]), "+v"(v[3]), "+v"(v[4]), "+v"(v[5]), "+v"(v[6]), "+v"(v[7]), "+v"(g[0]) : "n"(N) : "memory");
    asm volatile("" : "+v"(v[8]), "+v"(v[9]), "+v"(v[10]), "+v"(v[11]), "+v"(v[12]), "+v"(v[13]), "+v"(v[14]), "+v"(v[15]), "+v"(g[1]) :: "memory");
}
__device__ __forceinline__ unsigned cvt_pk(float lo, float hi) { unsigned r; asm volatile("v_cvt_pk_bf16_f32 %0, %1, %2" : "=v"(r) : "v"(lo), "v"(hi)); return r; }
__device__ __forceinline__ void cvt_store(const CvtItem& I, const f32x4 (&v)[16], const f32x4 (&g)[2], LAS float* scr, int lane) {
    const int f = lane & 15;
#pragma unroll
    for (int i = 0; i < 16; ++i) { const f32x4 w = (I.flags & 1) ? (f32x4){0.f, 0.f, 0.f, 0.f} : v[i];
        LAS float* d = scr + (4 * i + (lane >> 4)) * 65 + f * 4; d[0] = w[0]; d[1] = w[1]; d[2] = w[2]; d[3] = w[3]; }
    LDS_WAIT(); asm volatile("" ::: "memory");
    const int c = lane & 7;
    const f32x4 one = {1.f, 1.f, 1.f, 1.f}, ga = (I.flags & 2) ? g[0] : one, gb = (I.flags & 2) ? g[1] : one;
#pragma unroll
    for (int j = 0; j < 8; ++j) { const int n = 8 * j + (lane >> 3); const LAS float* s = scr + (8 * c) * 65 + n;
        v4u o; o.x = cvt_pk(s[0 * 65] * ga[0], s[1 * 65] * ga[1]); o.y = cvt_pk(s[2 * 65] * ga[2], s[3 * 65] * ga[3]);
        o.z = cvt_pk(s[4 * 65] * gb[0], s[5 * 65] * gb[1]); o.w = cvt_pk(s[6 * 65] * gb[2], s[7 * 65] * gb[3]);
        __builtin_nontemporal_store(o, (v4u*)(I.dp + (8 * j) * 64)); }
    LDS_WAIT(); asm volatile("" ::: "memory");
}
__device__ __forceinline__ void rms_row_to_bf16(const float* __restrict__ xrow, const float* __restrict__ g, bf16* __restrict__ orow, int lane) {
    const f32x4* xr = (const f32x4*)xrow + lane; const f32x4* gr = (const f32x4*)g + lane;
    f32x4 v[8]; float s = 0.f;
#pragma unroll
    for (int j = 0; j < 8; ++j) { v[j] = xr[64 * j]; s += (v[j].x * v[j].x + v[j].y * v[j].y) + (v[j].z * v[j].z + v[j].w * v[j].w); }
    const float rstd = 1.0f / sqrtf(wave_sum(s) * (1.0f / D_MODEL) + NORM_EPS);
    unsigned long long* o8 = (unsigned long long*)orow + lane;
#pragma unroll
    for (int j = 0; j < 8; ++j) { const f32x4 gv = gr[64 * j];
        o8[64 * j] = (unsigned long long)pk2(v[j].x * rstd * gv.x, v[j].y * rstd * gv.y) | ((unsigned long long)pk2(v[j].z * rstd * gv.z, v[j].w * rstd * gv.w) << 32); }
}
__device__ __forceinline__ void stream_rows_init(const float* __restrict__ x, bf16* __restrict__ XB, float* __restrict__ SS, int gw, int ngw, int lane) {
    int m = gw; if (m >= M) return;
    f32x4 v[8];
#pragma unroll
    for (int j = 0; j < 8; ++j) v[j] = __builtin_nontemporal_load((const f32x4*)(x + (size_t)m * D_MODEL) + lane + 64 * j);
    auto emit = [&](const f32x4 (&w)[8], int row) { float s = 0.f;
#pragma unroll
        for (int j = 0; j < 8; ++j) s += (w[j].x * w[j].x + w[j].y * w[j].y) + (w[j].z * w[j].z + w[j].w * w[j].w);
        s = wave_sum(s);
        unsigned long long* o8 = (unsigned long long*)(XB + (size_t)row * D_MODEL) + lane;
#pragma unroll
        for (int j = 0; j < 8; ++j) o8[64 * j] = (unsigned long long)pk2(w[j].x, w[j].y) | ((unsigned long long)pk2(w[j].z, w[j].w) << 32);
        if (lane < 2) *((f32x4*)(SS + (size_t)row * 8) + lane) = (f32x4){lane == 0 ? s : 0.f, 0.f, 0.f, 0.f}; };
    while (m + ngw < M) { const int nx = m + ngw; f32x4 vn[8];
#pragma unroll
        for (int j = 0; j < 8; ++j) vn[j] = __builtin_nontemporal_load((const f32x4*)(x + (size_t)nx * D_MODEL) + lane + 64 * j);
        emit(v, m); m = nx;
#pragma unroll
        for (int j = 0; j < 8; ++j) v[j] = vn[j]; }
    emit(v, m);
}
template <class Decode> __device__ __forceinline__ void cvt_run(const Decode& decode, int first, int stride, int last, LAS float* scr, int lane) {
    if (first >= last) return;
    auto item = [&](int it, const CvtItem& prev) -> CvtItem { if (it < last) return decode(it); CvtItem d = prev; d.Nsrc = 0; return d; };
    int it = first; CvtItem A = decode(it), B; f32x4 va[16], ga[2], vb[16], gb[2];
    cvt_load(A, va, ga); it += stride; B = item(it, A); cvt_load(B, vb, gb);
    cvt_wait<18>(va, ga); cvt_store(A, va, ga, scr, lane);
    while (it < last) {
        A = item(it + stride, B); cvt_load(A, va, ga);
        cvt_wait<26>(vb, gb); cvt_store(B, vb, gb, scr, lane); it += stride;
        if (it >= last) break;
        B = item(it + stride, A); cvt_load(B, vb, gb);
        cvt_wait<26>(va, ga); cvt_store(A, va, ga, scr, lane); it += stride;
    }
    asm volatile("s_waitcnt vmcnt(0)" ::: "memory");
}
__device__ __forceinline__ void p0a_prologue(const Ptrs& T, LAS unsigned char* lds, int gw, int ngw, int wave, int lane) {
    LAS float* scr = (LAS float*)(lds + wave * 16640);
    constexpr int I_MKV = (2 * MEM_W / 64) * (D_MODEL / 64);
    auto decode = [&](int it) -> CvtItem { const int l = it / I_MKV, r = it - l * I_MKV; constexpr int nb = 2 * MEM_W / 64;
        return cvt_make(T.w_mkv + (size_t)l * D_MODEL * 2 * MEM_W, T.w_mkv, nullptr, 2 * MEM_W, D_MODEL, T.WMKV + (size_t)l * 2 * MEM_W * D_MODEL, K_PLAIN, (r % nb) * 64, (r / nb) * 64, lane); };
    cvt_run(decode, gw, ngw, 2 * I_MKV, scr, lane);
    for (int m = gw; m < MROWS; m += ngw)
        for (int l = 0; l < DEPTH; ++l) rms_row_to_bf16(T.mem + (size_t)m * D_MODEL, T.mem_g + l * D_MODEL, T.MEMN + ((size_t)l * MROWS + m) * D_MODEL, lane);
    stream_rows_init(T.x_in, T.XB, T.SS, gw, ngw, lane);
}
constexpr int I_GU = (2 * D_FF / 64) * (D_MODEL / 64), I_WD = (D_MODEL / 64) * (D_FF / 64), I_IN0 = (SB_IN_W / 64) * (D_MODEL / 64), I_IN1 = (IN1_ROWS / 64) * (D_MODEL / 64), I_OUT = (D_MODEL / 64) * (D_MODEL / 64);
constexpr int I_GUH = I_GU / 2;
constexpr int CVT_EARLY = 3 * I_GU + I_GUH + 3 * I_WD + I_IN0 + I_IN1 + I_OUT, CVT_ALL = CVT_EARLY + I_GUH + I_WD + I_OUT;
static_assert(CVT_ALL == 4 * I_GU + 4 * I_WD + I_IN0 + I_IN1 + 2 * I_OUT && I_GU % 2 == 0, "item list");
__device__ __forceinline__ CvtItem cvt_decode(const Ptrs& T, int it, int lane) {
    int r = it; const float* src; const float* src2 = nullptr; const float* gain = nullptr; bf16* dst; int Nsrc, K, ndst, kind = K_PLAIN, f = -1;
    if (r < 3 * I_GU + I_GUH) { f = r / I_GU; r -= f * I_GU; }
    else if ((r -= 3 * I_GU + I_GUH) < 3 * I_WD) { const int fd = r / I_WD; r -= fd * I_WD; src = T.w_down + (size_t)fd * D_FF * D_MODEL; dst = T.WD + (size_t)fd * D_MODEL * D_FF; Nsrc = D_MODEL; K = D_FF; ndst = D_MODEL; }
    else if ((r -= 3 * I_WD) < I_IN0) { src = T.w_in0; gain = T.mix_g; dst = T.WIN0; Nsrc = SB_IN_W; K = D_MODEL; ndst = SB_IN_W; }
    else if ((r -= I_IN0) < I_IN1) { src = T.w_in1; gain = T.mix_g + D_MODEL; dst = T.WIN1; Nsrc = SWA_IN_W; K = D_MODEL; ndst = IN1_ROWS; kind = K_IN1; }
    else if ((r -= I_IN1) < I_OUT) { src = T.w_out; dst = T.WOUT; Nsrc = D_MODEL; K = D_MODEL; ndst = D_MODEL; }
    else if ((r -= I_OUT) < I_GUH) { f = 3; r += I_GUH; }
    else if ((r -= I_GUH) < I_WD) { src = T.w_down + (size_t)3 * D_FF * D_MODEL; dst = T.WD + (size_t)3 * D_MODEL * D_FF; Nsrc = D_MODEL; K = D_FF; ndst = D_MODEL; }
    else { r -= I_WD; src = T.w_out + (size_t)D_MODEL * D_MODEL; dst = T.WOUT + (size_t)D_MODEL * D_MODEL; Nsrc = D_MODEL; K = D_MODEL; ndst = D_MODEL; }
    if (f >= 0) { src = T.w_gate + (size_t)f * D_MODEL * D_FF; src2 = T.w_up + (size_t)f * D_MODEL * D_FF; gain = T.ffn_g + f * D_MODEL; dst = T.WGU + (size_t)f * 2 * D_FF * D_MODEL; Nsrc = D_FF; K = D_MODEL; ndst = 2 * D_FF; kind = K_GU; }
    const int nb = ndst / 64, n0 = (r % nb) * 64, k0 = (r / nb) * 64;
    return cvt_make(src, src2 ? src2 : src, gain, Nsrc, K, dst, kind, n0, k0, lane);
}
__device__ __forceinline__ void p0b_prologue(const Ptrs& T, LAS unsigned char* lds, int vcu, int G, int wave, int lane) {
    LAS float* scr = (LAS float*)(lds + wave * 16640);
    static_assert(DEPTH == 2, "item list written out for two layers");
    auto decode = [&](int it) -> CvtItem { return cvt_decode(T, it, lane); };
    if (G == 256) {
        constexpr int NA = 16 * NWAVES, SHARE_A = 3, SHARE_B = 17, NB = (256 - 16) * NWAVES, NITEMS = CVT_EARLY;
        static_assert(NA * SHARE_A + NB * SHARE_B == NITEMS, "conversion shares");
        const int w = vcu * NWAVES + wave;
        if (vcu < 16) {
            { pg8::Gemm g{T.MEMN, T.WMKV, MROWS, 2 * MEM_W, D_MODEL};
                pg8::StaticOrder S; S.init(MROWS, 2 * MEM_W, G, vcu);
                pg8::EpiBf16S E{T.KVM, 2 * MEM_W, 0, 1.f, nullptr, NORM_EPS, {}};
                pg8::gemm_phase<pg8::EpiBf16S, pg8::StaticOrder, PG8_ALIGN, PG8_SP2>(lds, g, S, E); }
            cvt_run(decode, w, NA, NA * SHARE_A, scr, lane);
        } else cvt_run(decode, NA * SHARE_A + (w - NA), NB, NITEMS, scr, lane);
    } else {
#pragma unroll
        for (int l = 0; l < DEPTH; ++l) { pg8::Gemm g{T.MEMN + (size_t)l * MROWS * D_MODEL, T.WMKV + (size_t)l * 2 * MEM_W * D_MODEL, MROWS, 2 * MEM_W, D_MODEL};
            pg8::StaticOrder S; S.init(MROWS, 2 * MEM_W, G, vcu);
            pg8::EpiBf16S E{T.KVM + (size_t)l * MROWS * 2 * MEM_W, 2 * MEM_W, 0, 1.f, nullptr, NORM_EPS, {}};
            pg8::gemm_phase<pg8::EpiBf16S, pg8::StaticOrder, PG8_ALIGN, PG8_SP2>(lds, g, S, E); }
        cvt_run(decode, vcu * NWAVES + wave, G * NWAVES, CVT_ALL, scr, lane);
    }
}

struct Args { const void* in[18]; float* out; unsigned char* ws; int ph_lo, ph_hi, li, pad; };
static_assert(sizeof(Args) == 18 * 8 + 8 + 8 + 16, "Args has no padding");
struct Ctx { Ptrs T; LAS unsigned char* lds; volatile LAS unsigned* MISC; XcdBarrier bar; int lo, hi, G, bx, vcu, gw, ngw, lane, wave; };
#define IN(k) (c.lo <= (k) && (k) < c.hi)
#define SEAM(k) do { if (IN(k) && IN((k) + 1)) xcd_barrier(c.bar); } while (0)
#define REPBAR() do { if (!MK_SPLIT) xcd_barrier(c.bar); } while (0)
#define RUN_PHASE(k, nrep, call0, call1) do { if (IN(k)) { call0; if constexpr ((nrep) >= 2) { REPBAR(); call1; } if constexpr ((nrep) >= 3) { REPBAR(); call1; } if constexpr ((nrep) >= 4) { REPBAR(); call1; } if constexpr ((nrep) >= 5) { REPBAR(); call1; } } } while (0)
template <int F> __device__ __forceinline__ void ph_up(const Ctx& c) {
    const Ptrs& T = c.T;
    pg8::Gemm g{T.XB, T.WGU + (size_t)F * 2 * D_FF * D_MODEL, M, 2 * D_FF, D_MODEL}; pg8::StaticOrder S; S.init(M, 2 * D_FF, c.G, c.bx);
    pg8::EpiSwiGLU E{T.ACT, D_FF, T.SS, NORM_EPS, {}};
    pg8::gemm_phase<pg8::EpiSwiGLU, pg8::StaticOrder, PG8_ALIGN, PG8_SP2>(c.lds, g, S, E);
}
template <int F, int R = 0> __device__ __forceinline__ void ph_down(const Ctx& c) {
    const Ptrs& T = c.T; pg8::Gemm g{T.ACT, T.WD + (size_t)F * D_MODEL * D_FF, M, D_MODEL, D_FF}; pg8::StaticOrder S; S.init(M, D_MODEL, c.G, c.bx, RES_WGM, DOWN_REV);
    constexpr bool FINAL = (F == 2 * DEPTH - 1);
    pg8::EpiResidB<FINAL> E{T.XB, T.out, T.SS, (LAS float*)(c.lds + TAB_OFF), D_MODEL, R == 0 ? 0.5f : 0.f};
    pg8::gemm_phase<pg8::EpiResidB<FINAL>, pg8::StaticOrder, true, PG8_SP2>(c.lds, g, S, E);
}
template <int L> __device__ __forceinline__ void ph_inproj(const Ctx& c) {
    const Ptrs& T = c.T;
    if constexpr (L % 2 == 0) { pg8::Gemm g{T.XB, T.WIN0, M, SB_IN_W, D_MODEL}; pg8::StaticOrder S; S.init(M, SB_IN_W, c.G, c.bx);
        pg8::EpiBf16S E{T.ACT, SB_IN_W, TOK_W / 256, 0.08838834764831845f * 1.4426950408889634f, T.SS, NORM_EPS, {}};
        pg8::gemm_phase<pg8::EpiBf16S, pg8::StaticOrder, PG8_ALIGN, PG8_SP2>(c.lds, g, S, E); }
    else { pg8::Gemm g{T.XB, T.WIN1, M, IN1_ROWS, D_MODEL}; pg8::StaticOrder S; S.init(M, IN1_ROWS, c.G, c.bx);
        pg8::EpiProjSWA E{T.ACT, IN1_ROWS, T.swa_qg, T.swa_kg, T.pos, 0.125f * 1.4426950408889634f, NORM_EPS, T.SS};
        pg8::gemm_phase<pg8::EpiProjSWA, pg8::StaticOrder, PG8_ALIGN, PG8_SP2>(c.lds, g, S, E);
        if (c.G == 256 && c.bx >= 128 && c.bx < 144) {
            pg8::Gemm gm{T.MEMN + (size_t)MROWS * D_MODEL, T.WMKV + (size_t)2 * MEM_W * D_MODEL, MROWS, 2 * MEM_W, D_MODEL}; pg8::StaticOrder Sm; Sm.init(MROWS, 2 * MEM_W, 16, c.bx - 128);
            pg8::EpiBf16S Em{T.KVM + (size_t)MROWS * 2 * MEM_W, 2 * MEM_W, 0, 1.f, nullptr, NORM_EPS, {}};
            pg8::gemm_phase<pg8::EpiBf16S, pg8::StaticOrder, PG8_ALIGN, PG8_SP2>(c.lds, gm, Sm, Em); }
        if (c.G == 256 && c.bx >= 144) {
            auto decode = [&](int it) -> CvtItem { return cvt_decode(T, it, c.lane); };
            cvt_run(decode, CVT_EARLY + (c.bx - 144) * NWAVES + c.wave, 112 * NWAVES, CVT_ALL, (LAS float*)(c.lds + c.wave * 16640), c.lane); } }
}
#ifndef ATT_LAYER
#define ATT_LAYER -1
#endif
#ifndef ATT_SEL
#define ATT_SEL 0
#endif
template <int L, int R = 0> __device__ __forceinline__ void ph_attn(const Ctx& c) {
    const Ptrs& T = c.T;
    volatile LAS int* flags = (volatile LAS int*)(c.MISC + 16);
    if (R == 0 || ATT_SEL == 0 || ATT_SEL == 1) {
    if constexpr (L % 2 == 0) {
        for (int u = c.vcu; u < BATCH * SB_HEADS * 16; u += c.G) { const int bh = u >> 4, qb = (u + (u >> 8) * 5) & 15;
            att::sb_unit(c.lds, flags, T.ACT, SB_IN_W, 0, TOK_W, 2 * TOK_W, T.MIX, bh / SB_HEADS, bh % SB_HEADS, qb); }
    } else {
        for (int u = c.vcu; u < BATCH * SWA_KV_HEADS * (SEQ / 64); u += c.G) { const int qi = u & 63, bk = u >> 6;
            att::swa_unit(c.lds, T.ACT, IN1_ROWS, T.sinks, T.MIX, bk / SWA_KV_HEADS, bk % SWA_KV_HEADS, qi); }
    } }
    if (R == 0 || ATT_SEL == 0 || ATT_SEL == 2) {
    constexpr int ldp = (L % 2 == 0) ? SB_IN_W : IN1_ROWS, qmc = (L % 2 == 0) ? 3 * TOK_W : TOK_W + 384;
    for (int u = c.vcu; u < BATCH * MEM_HEADS * 16; u += c.G)
        att::mem_unit(c.lds, T.ACT, ldp, qmc, T.KVM + (size_t)L * MROWS * 2 * MEM_W, T.memq_g + L * MEM_HD, T.memk_g + L * MEM_HD, T.MIX, u >> 6, (u >> 4) & 3, u & 15); }
}
template <int L, int R = 0> __device__ __forceinline__ void ph_outproj(const Ctx& c) {
    const Ptrs& T = c.T; pg8::Gemm g{T.MIX, T.WOUT + (size_t)L * D_MODEL * D_MODEL, M, D_MODEL, D_MODEL}; pg8::StaticOrder S; S.init(M, D_MODEL, c.G, c.bx, RES_WGM);
    pg8::EpiResidB<false> E{T.XB, T.out, T.SS, (LAS float*)(c.lds + TAB_OFF), D_MODEL, R == 0 ? 1.0f : 0.f};
    pg8::gemm_phase<pg8::EpiResidB<false>, pg8::StaticOrder, true, PG8_SP2>(c.lds, g, S, E);
}
template <int L> __device__ __forceinline__ void layer_phases(const Ctx& c, int pb) {
    RUN_PHASE(pb + 0, REP_GU, ph_up<2 * L>(c), ph_up<2 * L>(c)); SEAM(pb + 0);
    RUN_PHASE(pb + 1, REP_RS, (ph_down<2 * L, 0>(c)), (ph_down<2 * L, 1>(c))); SEAM(pb + 1);
    RUN_PHASE(pb + 2, REP_PJ, ph_inproj<L>(c), ph_inproj<L>(c)); SEAM(pb + 2);
    RUN_PHASE(pb + 3, (ATT_LAYER < 0 || ATT_LAYER == L ? REP_AT : 1), (ph_attn<L, 0>(c)), (ph_attn<L, 1>(c))); SEAM(pb + 3);
    RUN_PHASE(pb + 4, REP_RS, (ph_outproj<L, 0>(c)), (ph_outproj<L, 1>(c))); SEAM(pb + 4);
    RUN_PHASE(pb + 5, REP_GU, ph_up<2 * L + 1>(c), ph_up<2 * L + 1>(c)); SEAM(pb + 5);
    RUN_PHASE(pb + 6, (2 * L + 1 == 2 * DEPTH - 1 ? 1 : REP_RS), (ph_down<2 * L + 1, 0>(c)), (ph_down<2 * L + 1, 1>(c))); SEAM(pb + 6);
}
__global__ void __launch_bounds__(NWAVES * 64, 2) mk_fwd(Args args) {
    extern __shared__ __attribute__((aligned(16))) unsigned char lds_raw[];
    Ctx c;
    c.lds = (LAS unsigned char*)lds_raw;
    c.MISC = (volatile LAS unsigned*)(c.lds + MISC_OFF);
    const int tid = threadIdx.x;
    c.lane = tid & 63; c.wave = __builtin_amdgcn_readfirstlane(tid >> 6);
    c.G = gridDim.x; c.bx = blockIdx.x;
    const int vcu = (c.G % 8 == 0) ? (c.bx % 8) * (c.G / 8) + c.bx / 8 : c.bx;
    c.vcu = vcu; c.gw = vcu * NWAVES + c.wave; c.ngw = c.G * NWAVES;
    unsigned char* ws = args.ws;
    unsigned* ctl = (unsigned*)(ws + WS_CTL);
    Ptrs& T = c.T;
    T.x_in = (const float*)args.in[0]; T.mem = (const float*)args.in[1]; T.pos = (const int*)args.in[2]; T.ffn_g = (const float*)args.in[3];
    T.w_gate = (const float*)args.in[4]; T.w_up = (const float*)args.in[5]; T.w_down = (const float*)args.in[6]; T.mix_g = (const float*)args.in[7];
    T.mem_g = (const float*)args.in[8]; T.w_mkv = (const float*)args.in[9]; T.memq_g = (const float*)args.in[10]; T.memk_g = (const float*)args.in[11];
    T.w_out = (const float*)args.in[12]; T.w_in0 = (const float*)args.in[13]; T.w_in1 = (const float*)args.in[14]; T.swa_qg = (const float*)args.in[15];
    T.swa_kg = (const float*)args.in[16]; T.sinks = (const float*)args.in[17];
    T.out = args.out;
    T.WGU = (bf16*)(ws + WS_WGU); T.WD = (bf16*)(ws + WS_WD); T.WIN0 = (bf16*)(ws + WS_WIN0); T.WIN1 = (bf16*)(ws + WS_WIN1); T.WOUT = (bf16*)(ws + WS_WOUT); T.WMKV = (bf16*)(ws + WS_WMKV);
    T.XB = (bf16*)(ws + WS_XB); T.ACT = (bf16*)(ws + WS_ACT); T.MIX = (bf16*)(ws + WS_MIX); T.MEMN = (bf16*)(ws + WS_MEMN); T.KVM = (bf16*)(ws + WS_KVM);
    T.SS = (float*)(ws + WS_SS);
    for (int u = tid; u < (LDS_BYTES - MISC_OFF) / 4; u += NWAVES * 64) ((LAS unsigned*)(c.lds + MISC_OFF))[u] = 0u;
    __syncthreads();
    c.bar.bar = ctl + CW_BAR; c.bar.x = 0; c.bar.st = nullptr;
    if (!MK_SPLIT) c.bar = xcd_barrier_post(ctl + CW_BAR, c.MISC + 8);
    c.lo = args.ph_lo; c.hi = args.ph_hi;

    RUN_PHASE(0, 1, p0a_prologue(T, c.lds, c.gw, c.ngw, c.wave, c.lane), p0a_prologue(T, c.lds, c.gw, c.ngw, c.wave, c.lane));
    SEAM(0);
    RUN_PHASE(1, REP_P0, p0b_prologue(T, c.lds, vcu, c.G, c.wave, c.lane), p0b_prologue(T, c.lds, vcu, c.G, c.wave, c.lane));
    SEAM(1);
    layer_phases<0>(c, 2);
    layer_phases<1>(c, 9);
    static_assert(DEPTH == 2 && NPHASE == 16, "phase program written out for two layers");
}
#undef IN
#undef SEAM
#undef RUN_PHASE
#undef REPBAR

extern "C" void kernel_launch(void* const* d_in, const int* in_sizes, int n_in, void* d_out, int out_size, void* d_ws, size_t ws_size, hipStream_t stream) {
    static int grid = 0;
    if (grid == 0) {
        if (n_in != 18 || out_size != M * D_MODEL || ws_size < WS_END) { fprintf(stderr, "kernel_launch: unexpected shapes (n_in %d out %d ws %zu need %zu)\n", n_in, out_size, ws_size, (size_t)WS_END); grid = -1; return; }
        int dev = 0, cus = 0, per_cu = 0;
        if (hipGetDevice(&dev) != hipSuccess || hipDeviceGetAttribute(&cus, hipDeviceAttributeMultiprocessorCount, dev) != hipSuccess) { grid = -1; return; }
        if (hipFuncSetAttribute((const void*)mk_fwd, hipFuncAttributeMaxDynamicSharedMemorySize, LDS_BYTES) != hipSuccess) { fprintf(stderr, "kernel_launch: hipFuncSetAttribute failed\n"); grid = -1; return; }
        if (hipOccupancyMaxActiveBlocksPerMultiprocessor(&per_cu, (const void*)mk_fwd, NWAVES * 64, LDS_BYTES) != hipSuccess || per_cu < 1) fprintf(stderr, "kernel_launch: occupancy query reports %d\n", per_cu);
        (void)hipGetLastError();
        grid = cus;
    }
    if (grid < 0) return;
    if (hipMemsetAsync((char*)d_ws + WS_CTL + (size_t)CW_BAR * 4, 0, (size_t)XCD_BAR_WORDS * 4, stream) != hipSuccess) return;
    Args a; memset(&a, 0, sizeof(a));
    for (int i = 0; i < 18; ++i) a.in[i] = d_in[i];
    a.out = (float*)d_out; a.ws = (unsigned char*)d_ws;
#if MK_SPLIT
    for (int p = 0; p < NPHASE; ++p) { a.ph_lo = p; a.ph_hi = p + 1; a.li = p; hipLaunchKernelGGL(mk_fwd, dim3(grid), dim3(NWAVES * 64), LDS_BYTES, stream, a); }
#else
    a.ph_lo = 0; a.ph_hi = NPHASE; a.li = 0;
    hipLaunchKernelGGL(mk_fwd, dim3(grid), dim3(NWAVES * 64), LDS_BYTES, stream, a);
#endif
}
```

```cpp
#include <hip/hip_runtime.h>
#include <cstdio>
#include <cstdint>
#include <cstring>
#include <type_traits>
constexpr int D_MODEL = 2048, BATCH = 4, SEQ = 4096, DEPTH = 2;
constexpr int M = BATCH * SEQ;
constexpr int MEM_LEN = 256, MEM_HEADS = 4, MEM_HD = 128, MEM_W = 512, TOK_W = 1536;
constexpr int SB_HD = 128, SB_HEADS = 12, SWA_HD = 64, SWA_HEADS = 24, SWA_GROUP = 8, SWA_KV_HEADS = 3, WINDOW = 128;
constexpr int D_FF = 5632;
constexpr int SB_IN_W = 3 * TOK_W + MEM_W;
constexpr int SWA_IN_W = TOK_W + 2 * SWA_KV_HEADS * SWA_HD + MEM_W;
constexpr float NORM_EPS = 1e-6f;
constexpr int MROWS = BATCH * MEM_LEN;
#define LAS __attribute__((address_space(3)))
#ifndef PG8_LATE
#define PG8_LATE 0
#endif
namespace pg8 {
#define PG8_LAS __attribute__((address_space(3)))
typedef unsigned short bf16_t;
typedef short bf16x8 __attribute__((ext_vector_type(8)));
typedef float f32x4 __attribute__((ext_vector_type(4)));
typedef unsigned u32x4 __attribute__((ext_vector_type(4)));
constexpr int BM = 256, BK = 64, HALF = 128, HTB = HALF * BK * 2  , STAGE_BYTES = 8 * HTB, NXCD = 8, WGM = 8;

__host__ __device__ __forceinline__ int lds_byte(int r, int c) { const int st = (r >> 4) * 2 + (c >> 5), rr = r & 15, cc = c & 31, ob = rr * 64 + cc * 2; return st * 1024 + (ob ^ (((ob >> 9) & 1) << 5)); }
__host__ __device__ __forceinline__ void stage_rc(int b, int& R, int& C) { const int st = b / 1024, sb = b % 1024, swz = sb ^ (((sb >> 9) & 1) << 5); R = (st >> 1) * 16 + swz / 64; C = (st & 1) * 32 + (swz % 64) / 2; }
__host__ __device__ __forceinline__ int perm32(int rho) { const int n = rho >> 4, i = rho & 15; return 8 * (i >> 2) + 4 * n + (i & 3); }

struct Unit { int pm, pn; };
struct Gemm { const bf16_t* A; const bf16_t* Bt; int M, N, K; };

struct StaticOrder {
    int nM, nN, nwg, G, c, wgm = WGM, rev = 0;
    __host__ __device__ void init(int M, int N, int G_, int c_, int wgm_ = WGM, int rev_ = 0) { nM = M / BM; nN = N / BM; nwg = nM * nN; G = G_; c = c_; wgm = wgm_; rev = rev_; }
    __host__ __device__ bool next(int i, Unit& u) const {
        const long L = (long)i * G + c; if (L >= nwg) return false;
        int wgid = (int)L; { const int q = nwg / NXCD, r = nwg % NXCD, xcd = wgid % NXCD, off = wgid / NXCD; wgid = (xcd < r ? xcd * (q + 1) : r * (q + 1) + (xcd - r) * q) + off; }
        const int nig = wgm * nN, gid = wgid / nig, fm = gid * wgm, gsz = (nM - fm) < wgm ? (nM - fm) : wgm;
        u.pm = fm + ((wgid % nig) % gsz); u.pn = (wgid % nig) / gsz; if (rev) u.pm = nM - 1 - u.pm; return true;
    }
    __device__ __forceinline__ void a_ready(const Unit&) const {}
    __device__ __forceinline__ void done(const Unit&) const {}
};
__device__ __forceinline__ unsigned cvt_pk_bf16(float lo, float hi) { unsigned r; asm volatile("v_cvt_pk_bf16_f32 %0, %1, %2" : "=v"(r) : "v"(lo), "v"(hi)); return r; }
typedef float f32x2 __attribute__((ext_vector_type(2)));
__device__ __forceinline__ float silu_mul(float g, float u) { return g * u * __builtin_amdgcn_rcpf(1.0f + __builtin_amdgcn_exp2f(-1.4426950408889634f * g)); }
__device__ __forceinline__ float bf_lo(unsigned w) { return __uint_as_float(w << 16); }
__device__ __forceinline__ float bf_hi(unsigned w) { return __uint_as_float(w & 0xffff0000u); }
__device__ __forceinline__ void load_rstd(const float* ss, int row0, float eps, float (&rs)[2][4]) {
#pragma unroll
    for (int ai = 0; ai < 2; ++ai) { f32x4 a[4], b[4];
#pragma unroll
        for (int m = 0; m < 4; ++m) { const float* p = ss + (size_t)(row0 + ai * HALF + m * 16) * 8; a[m] = *(const f32x4*)p; b[m] = *(const f32x4*)(p + 4); }
#pragma unroll
        for (int m = 0; m < 4; ++m) { const f32x4 x = a[m], y = b[m];
            rs[ai][m] = __builtin_amdgcn_rsqf((((x[0] + x[1]) + (x[2] + x[3])) + ((y[0] + y[1]) + (y[2] + y[3]))) * (1.0f / 2048.0f) + eps); } }
}
struct RstdCache { mutable int pm = -1; mutable float rs[2][4];
    __device__ __forceinline__ void get(const float* ss, const Unit& u, int row0, float eps) const { if (u.pm != pm) { load_rstd(ss, row0, eps, rs); pm = u.pm; } } };
struct EpiSwiGLU {
    static constexpr bool PERM = true, AFTER_DRAIN = false; static constexpr int NSTORE = 8;
    bf16_t* O; int ldc; const float* ss; float eps; RstdCache rc;
    static __device__ __forceinline__ f32x2 act2(f32x2 g, f32x2 u, float c, float s) { const f32x2 t = g * c;
        f32x2 e; e.x = __builtin_amdgcn_exp2f(t.x); e.y = __builtin_amdgcn_exp2f(t.y); e = e * s + s;
        f32x2 q; q.x = __builtin_amdgcn_rcpf(e.x); q.y = __builtin_amdgcn_rcpf(e.y); return (g * u) * q; }
    __device__ __forceinline__ void operator()(const f32x4 (&acc)[2][2][4][2], const Unit& u, int wr, int wc, int fr, int fq) const {
        const int row0 = u.pm * BM + wr * 64 + fr, col0 = u.pn * HALF + wc * 32 + 8 * fq;
        rc.get(ss, u, row0, eps); const float (&rs)[2][4] = rc.rs;
#pragma unroll
        for (int ai = 0; ai < 2; ++ai)
#pragma unroll
            for (int m = 0; m < 4; ++m) { bf16_t* rowp = O + (size_t)(row0 + ai * HALF + m * 16) * ldc + col0; const float r = rs[ai][m], cc = r * -1.4426950408889634f, sq = __builtin_amdgcn_rcpf(r * r);
                const f32x4 g0 = acc[ai][0][m][0], g1 = acc[ai][0][m][1], u0 = acc[ai][1][m][0], u1 = acc[ai][1][m][1];
                const f32x2 a = act2((f32x2){g0[0], g0[1]}, (f32x2){u0[0], u0[1]}, cc, sq), b = act2((f32x2){g0[2], g0[3]}, (f32x2){u0[2], u0[3]}, cc, sq);
                const f32x2 c = act2((f32x2){g1[0], g1[1]}, (f32x2){u1[0], u1[1]}, cc, sq), d = act2((f32x2){g1[2], g1[3]}, (f32x2){u1[2], u1[3]}, cc, sq);
                u32x4 w; w.x = cvt_pk_bf16(a.x, a.y); w.y = cvt_pk_bf16(b.x, b.y); w.z = cvt_pk_bf16(c.x, c.y); w.w = cvt_pk_bf16(d.x, d.y);
                *(u32x4*)rowp = w; }
    }
};
template <bool FINAL> struct EpiResidB {
    static constexpr bool PERM = true, AFTER_DRAIN = false; static constexpr int NSTORE = 0;
    bf16_t* XB; float* outf; float* ss; PG8_LAS float* tab; int ldc; float alpha;
    __device__ __forceinline__ void operator()(const f32x4 (&acc)[2][2][4][2], const Unit& u, int wr, int wc, int fr, int fq) const {
        const int row0 = u.pm * BM + wr * 64 + fr, col0 = u.pn * BM + wc * 32 + 8 * fq;
        u32x4 xv[2][4][2];
#pragma unroll
        for (int ai = 0; ai < 2; ++ai)
#pragma unroll
            for (int m = 0; m < 4; ++m)
#pragma unroll
                for (int bj = 0; bj < 2; ++bj) xv[ai][m][bj] = *(const u32x4*)(XB + (size_t)(row0 + ai * HALF + m * 16) * ldc + col0 + bj * HALF);
#pragma unroll
        for (int ai = 0; ai < 2; ++ai)
#pragma unroll
            for (int m = 0; m < 4; ++m) { const size_t off = (size_t)(row0 + ai * HALF + m * 16) * ldc + col0; float s = 0.f;
#pragma unroll
                for (int bj = 0; bj < 2; ++bj) { const u32x4 x = xv[ai][m][bj]; const f32x4 a0 = acc[ai][bj][m][0] * alpha, a1 = acc[ai][bj][m][1] * alpha;
                    const f32x4 v0 = {bf_lo(x.x) + a0[0], bf_hi(x.x) + a0[1], bf_lo(x.y) + a0[2], bf_hi(x.y) + a0[3]};
                    const f32x4 v1 = {bf_lo(x.z) + a1[0], bf_hi(x.z) + a1[1], bf_lo(x.w) + a1[2], bf_hi(x.w) + a1[3]};
                    if constexpr (FINAL) { *(f32x4*)(outf + off + bj * HALF) = v0; *(f32x4*)(outf + off + bj * HALF + 4) = v1; }
                    else { s += ((v0[0] * v0[0] + v0[1] * v0[1]) + (v0[2] * v0[2] + v0[3] * v0[3])) + ((v1[0] * v1[0] + v1[1] * v1[1]) + (v1[2] * v1[2] + v1[3] * v1[3]));
                        u32x4 w; w.x = cvt_pk_bf16(v0[0], v0[1]); w.y = cvt_pk_bf16(v0[2], v0[3]); w.z = cvt_pk_bf16(v1[0], v1[1]); w.w = cvt_pk_bf16(v1[2], v1[3]);
                        *(u32x4*)(XB + off + bj * HALF) = w; } }
                if constexpr (!FINAL) { s += __shfl_xor(s, 16); s += __shfl_xor(s, 32); if (fq == 0) tab[(ai * HALF + wr * 64 + m * 16 + fr) * 4 + wc] = s; } }
        if constexpr (!FINAL) {
            asm volatile("s_waitcnt lgkmcnt(0)" ::: "memory"); __builtin_amdgcn_s_barrier(); asm volatile("" ::: "memory");
            const int t = threadIdx.x;
            if (t < BM) { const f32x4 p = *(const PG8_LAS f32x4*)(tab + t * 4); ss[(size_t)(u.pm * BM + t) * 8 + u.pn] = (p[0] + p[1]) + (p[2] + p[3]); }
        }
    }
};
struct EpiBf16S {
    static constexpr bool PERM = true, AFTER_DRAIN = false; static constexpr int NSTORE = 16;
    bf16_t* O; int ldc; int q_tiles; float qscale; const float* ss; float eps; RstdCache rc;
    __device__ __forceinline__ void operator()(const f32x4 (&acc)[2][2][4][2], const Unit& u, int wr, int wc, int fr, int fq) const {
        const int row0 = u.pm * BM + wr * 64 + fr, col0 = u.pn * BM + wc * 32 + 8 * fq; const float sc = u.pn < q_tiles ? qscale : 1.f;
        if (ss) rc.get(ss, u, row0, eps);
        else if (rc.pm != -2) { rc.pm = -2;
#pragma unroll
            for (int ai = 0; ai < 2; ++ai)
#pragma unroll
                for (int m = 0; m < 4; ++m) rc.rs[ai][m] = 1.f; }
        const float (&rs)[2][4] = rc.rs;
#pragma unroll
        for (int ai = 0; ai < 2; ++ai)
#pragma unroll
            for (int m = 0; m < 4; ++m) { bf16_t* rowp = O + (size_t)(row0 + ai * HALF + m * 16) * ldc + col0; const float r = rs[ai][m] * sc;
#pragma unroll
                for (int bj = 0; bj < 2; ++bj) { const f32x4 v0 = acc[ai][bj][m][0] * r, v1 = acc[ai][bj][m][1] * r;
                    u32x4 w; w.x = cvt_pk_bf16(v0[0], v0[1]); w.y = cvt_pk_bf16(v0[2], v0[3]); w.z = cvt_pk_bf16(v1[0], v1[1]); w.w = cvt_pk_bf16(v1[2], v1[3]);
                    *(u32x4*)(rowp + bj * HALF) = w; } }
    }
};
struct EpiProjSWA {
    static constexpr bool PERM = true, AFTER_DRAIN = false; static constexpr int NSTORE = 0;
    bf16_t* O; int ldc; const float* qg; const float* kg; const int* pos; float qscale; float eps; const float* ss;
    __device__ __forceinline__ void operator()(const f32x4 (&acc)[2][2][4][2], const Unit& u, int wr, int wc, int fr, int fq) const {
        const int pn = u.pn, row0 = u.pm * BM + wr * 64 + fr;
        if (pn == 6 && wc == 3) return;
        const float* g = pn < 6 ? qg : kg; const float sc = pn < 6 ? qscale : 1.f;
        const int colbase = (pn < 6 ? (4 * pn + wc) * 64 : 1536 + wc * 64) + 8 * fq;
        f32x4 gv[2][2];
        if (pn <= 6) {
#pragma unroll
            for (int bj = 0; bj < 2; ++bj)
#pragma unroll
                for (int n = 0; n < 2; ++n) gv[bj][n] = *(const f32x4*)(g + 32 * bj + 8 * fq + 4 * n); }
#pragma unroll
        for (int ai = 0; ai < 2; ++ai) {
            float rs[4]; int pv[4];
            { f32x4 a[4], b[4];
#pragma unroll
              for (int m = 0; m < 4; ++m) { const int r = row0 + ai * HALF + m * 16; const float* p = ss + (size_t)r * 8; a[m] = *(const f32x4*)p; b[m] = *(const f32x4*)(p + 4); pv[m] = pos[r]; }
#pragma unroll
              for (int m = 0; m < 4; ++m) { const f32x4 x = a[m], y = b[m];
                  rs[m] = __builtin_amdgcn_rsqf((((x[0] + x[1]) + (x[2] + x[3])) + ((y[0] + y[1]) + (y[2] + y[3]))) * (1.0f / 2048.0f) + eps); } }
            if (pn <= 6) {
#pragma unroll
                for (int m = 0; m < 4; ++m) { const int r = row0 + ai * HALF + m * 16; const float rr = rs[m], pf = (float)pv[m];
                    float ss2 = 0.f;
#pragma unroll
                    for (int bj = 0; bj < 2; ++bj)
#pragma unroll
                        for (int n = 0; n < 2; ++n) { const f32x4 x = acc[ai][bj][m][n]; ss2 += (x[0] * x[0] + x[1] * x[1]) + (x[2] * x[2] + x[3] * x[3]); }
                    ss2 += __shfl_xor(ss2, 16); ss2 += __shfl_xor(ss2, 32);
                    const float rstd = __builtin_amdgcn_rsqf(ss2 * rr * rr * (1.0f / 64.0f) + eps) * sc * rr;
                    u32x4 w1, w2;
#pragma unroll
                    for (int n = 0; n < 2; ++n) { f32x4 c, s;
#pragma unroll
                        for (int j = 0; j < 4; ++j) { const float fi = __builtin_amdgcn_exp2f(-0.41524101186092029f * (float)(8 * fq + 4 * n + j)) * 0.15915494309189535f;
                            const float t = __builtin_amdgcn_fractf(pf * fi); c[j] = __builtin_amdgcn_cosf(t); s[j] = __builtin_amdgcn_sinf(t); }
                        const f32x4 x1 = acc[ai][0][m][n] * gv[0][n] * rstd, x2 = acc[ai][1][m][n] * gv[1][n] * rstd;
                        const f32x4 o1 = x1 * c - x2 * s, o2 = x2 * c + x1 * s;
                        if (n == 0) { w1.x = cvt_pk_bf16(o1[0], o1[1]); w1.y = cvt_pk_bf16(o1[2], o1[3]); w2.x = cvt_pk_bf16(o2[0], o2[1]); w2.y = cvt_pk_bf16(o2[2], o2[3]); }
                        else        { w1.z = cvt_pk_bf16(o1[0], o1[1]); w1.w = cvt_pk_bf16(o1[2], o1[3]); w2.z = cvt_pk_bf16(o2[0], o2[1]); w2.w = cvt_pk_bf16(o2[2], o2[3]); } }
                    bf16_t* rowp = O + (size_t)r * ldc + colbase;
                    *(u32x4*)rowp = w1; *(u32x4*)(rowp + 32) = w2; }
            } else {
#pragma unroll
                for (int bj = 0; bj < 2; ++bj) { const int p = bj * HALF + wc * 32 + 8 * fq;
                    if (pn == 7 && p >= 192) continue;
                    const int col = pn == 7 ? 1728 + p : 1920 + (pn - 8) * 256 + p;
#pragma unroll
                    for (int m = 0; m < 4; ++m) { const float rr = rs[m]; const f32x4 v0 = acc[ai][bj][m][0] * rr, v1 = acc[ai][bj][m][1] * rr;
                        u32x4 w; w.x = cvt_pk_bf16(v0[0], v0[1]); w.y = cvt_pk_bf16(v0[2], v0[3]); w.z = cvt_pk_bf16(v1[0], v1[1]); w.w = cvt_pk_bf16(v1[2], v1[3]);
                        *(u32x4*)(O + (size_t)(row0 + ai * HALF + m * 16) * ldc + col) = w; } }
            }
        }
    }
};
template <class Epi, class Sched, bool ALIGN_EPI = false, bool SP2 = false>
__device__ __forceinline__ void gemm_phase(PG8_LAS unsigned char* lds, const Gemm g, const Sched& S, const Epi& E) {
    const int tid = threadIdx.x, wid = __builtin_amdgcn_readfirstlane(tid >> 6), lane = tid & 63, wr = wid >> 2, wc = wid & 3, fr = lane & 15, fq = lane >> 4;
    const int K = g.K, nt = K / BK;
    unsigned voffA[2], voffB[2];
#pragma unroll
    for (int i = 0; i < 2; ++i) { int R, C; stage_rc(tid * 16 + i * 8192, R, C); const int Rb = Epi::PERM ? ((R & ~31) + perm32(R & 31)) : R;
        voffA[i] = (unsigned)(R * K + C) * 2u; voffB[i] = (unsigned)(Rb * BK + C) * 2u; }
    const size_t kstep = (size_t)(BK * 2);
    const size_t kstepB = (size_t)BM * BK * 2, hstepB = (size_t)HALF * BK * 2;
    const size_t hstep = (size_t)HALF * K * 2;
    const size_t tstep = 2 * hstep;
    const unsigned ldsw = (unsigned)wid * 1024u;
    const int aoff = lds_byte(wr * 64 + fr, fq * 8), boff = lds_byte(wc * 32 + fr, fq * 8);
#define PG8_SA(b, h) (((b) * 2 + (h)) * HTB)
#define PG8_SB(b, h) ((4 + (b) * 2 + (h)) * HTB)
#define PG8_STAGE(bufoff, gbase, voff) do { _Pragma("unroll") for (int _i = 0; _i < 2; ++_i) \
        __builtin_amdgcn_global_load_lds((const unsigned*)((const char*)(gbase) + (voff)[_i]), (PG8_LAS unsigned*)(lds + (bufoff) + ldsw + _i * 8192), 16, 0, 0); } while (0)
#define PG8_LDA(dst, b, h) do { _Pragma("unroll") for (int m = 0; m < 4; ++m) _Pragma("unroll") for (int k = 0; k < 2; ++k) dst[m][k] = *(const PG8_LAS bf16x8*)(lds + PG8_SA(b, h) + aoff + m * 2048 + k * 1024); } while (0)
#define PG8_LDB(dst, b, h) do { _Pragma("unroll") for (int n = 0; n < 2; ++n) _Pragma("unroll") for (int k = 0; k < 2; ++k) dst[n][k] = *(const PG8_LAS bf16x8*)(lds + PG8_SB(b, h) + boff + n * 2048 + k * 1024); } while (0)
#define PG8_MMA(ai, bj, At, Bt) do { __builtin_amdgcn_s_setprio(1); _Pragma("unroll") for (int m = 0; m < 4; ++m) _Pragma("unroll") for (int n = 0; n < 2; ++n) _Pragma("unroll") for (int k = 0; k < 2; ++k) \
        acc[ai][bj][m][n] = __builtin_amdgcn_mfma_f32_16x16x32_bf16(Bt[n][k], At[m][k], acc[ai][bj][m][n], 0, 0, 0); __builtin_amdgcn_s_setprio(0); } while (0)
#define PG8_WAIT_V(n) asm volatile("s_waitcnt vmcnt(" #n ")" ::: "memory")
#define PG8_WAIT_V8R(relaxed) do { if constexpr (Epi::NSTORE > 0) asm volatile("s_cmp_lg_u32 %0, 0\n\ts_cbranch_scc1 .Lpg8r%=\n\ts_waitcnt vmcnt(8)\n.Lpg8r%=:\n\ts_waitcnt vmcnt(%1)" :: "s"(relaxed), "n"(8 + Epi::NSTORE) : "memory", "scc"); \
        else asm volatile("s_waitcnt vmcnt(8)" ::: "memory"); } while (0)
#define PG8_WAIT_L(n) asm volatile("s_waitcnt lgkmcnt(" #n ")" ::: "memory")
#define PG8_BAR __builtin_amdgcn_s_barrier()
#define PG8_SCHED __builtin_amdgcn_sched_barrier(0)
    Unit cur, nxt; int ui = 0;
    if (!S.next(0, cur)) return;
    f32x4 acc[2][2][4][2];
#pragma unroll
    for (int a = 0; a < 2; ++a)
#pragma unroll
        for (int b = 0; b < 2; ++b)
#pragma unroll
            for (int m = 0; m < 4; ++m)
#pragma unroll
                for (int n = 0; n < 2; ++n) acc[a][b][m][n] = (f32x4){0.f, 0.f, 0.f, 0.f};
    bf16x8 At[4][2], B0[2][2], B1[2][2];
    const char* cA = (const char*)g.A + (size_t)cur.pm * tstep; const char* cB = (const char*)g.Bt + (size_t)cur.pn * tstep;
    S.a_ready(cur);
    if constexpr (SP2) {
        PG8_STAGE(PG8_SB(0, 0), cB, voffB); PG8_STAGE(PG8_SB(0, 1), cB + hstepB, voffB); PG8_STAGE(PG8_SA(0, 0), cA, voffA); PG8_STAGE(PG8_SA(0, 1), cA + hstep, voffA);
        if (wr == 1) PG8_BAR;
        PG8_WAIT_V(2); PG8_BAR;
        PG8_STAGE(PG8_SB(1, 0), cB + kstepB, voffB); PG8_STAGE(PG8_SA(1, 0), cA + kstep, voffA); PG8_STAGE(PG8_SB(1, 1), cB + hstepB + kstepB, voffB);
        PG8_WAIT_V(6); PG8_BAR;
    } else {
        PG8_STAGE(PG8_SB(0, 0), cB, voffB); PG8_STAGE(PG8_SA(0, 0), cA, voffA); PG8_STAGE(PG8_SB(0, 1), cB + hstepB, voffB); PG8_STAGE(PG8_SA(0, 1), cA + hstep, voffA);
        if (wr == 1) PG8_BAR;
        PG8_WAIT_V(4); PG8_BAR;
        PG8_STAGE(PG8_SB(1, 0), cB + kstepB, voffB); PG8_STAGE(PG8_SA(1, 0), cA + kstep, voffA); PG8_STAGE(PG8_SB(1, 1), cB + hstepB + kstepB, voffB);
        PG8_WAIT_V(6); PG8_BAR;
    }
    for (;;) {
        const bool has_next = S.next(ui + 1, nxt);
        const char* nA = has_next ? (const char*)g.A + (size_t)nxt.pm * tstep : cA; const char* nB = has_next ? (const char*)g.Bt + (size_t)nxt.pn * tstep : cB;
        for (int t = 0; t < nt; t += 2) {
            const bool last = (t == nt - 2);
            const char* a1 = cA + (size_t)(t + 1) * kstep;
            const char* a2 = last ? nA : cA + (size_t)(t + 2) * kstep; const char* b2 = last ? nB : cB + (size_t)(t + 2) * kstepB;
            const char* a3 = a2 + kstep; const char* b3 = b2 + kstepB;
            if (last && has_next) S.a_ready(nxt);
            if constexpr (SP2) {
            const int after_epi = __builtin_amdgcn_readfirstlane((t == 0 && ui > 0) ? 1 : 0);
            PG8_LDB(B0, 0, 0); PG8_LDB(B1, 0, 1); PG8_SCHED; PG8_LDA(At, 0, 0); PG8_STAGE(PG8_SA(1, 1), a1 + hstep, voffA);
            PG8_WAIT_V8R(after_epi); PG8_WAIT_L(0); PG8_BAR; PG8_MMA(0, 0, At, B0); PG8_MMA(0, 1, At, B1); PG8_BAR; PG8_SCHED;
#if PG8_LATE == 2
            PG8_LDA(At, 0, 1); PG8_STAGE(PG8_SB(0, 0), b2, voffB);
            PG8_WAIT_V(4); PG8_WAIT_L(0); PG8_BAR; PG8_MMA(1, 0, At, B0); PG8_SCHED; PG8_STAGE(PG8_SB(0, 1), b2 + hstepB, voffB); PG8_STAGE(PG8_SA(0, 0), a2, voffA); PG8_SCHED; PG8_MMA(1, 1, At, B1); PG8_BAR; PG8_SCHED;
#elif PG8_LATE == 1
            PG8_LDA(At, 0, 1); PG8_STAGE(PG8_SB(0, 0), b2, voffB); PG8_STAGE(PG8_SB(0, 1), b2 + hstepB, voffB);
            PG8_WAIT_V(6); PG8_WAIT_L(0); PG8_BAR; PG8_MMA(1, 0, At, B0); PG8_SCHED; PG8_STAGE(PG8_SA(0, 0), a2, voffA); PG8_SCHED; PG8_MMA(1, 1, At, B1); PG8_BAR; PG8_SCHED;
#else
            PG8_LDA(At, 0, 1); PG8_STAGE(PG8_SB(0, 0), b2, voffB); PG8_STAGE(PG8_SB(0, 1), b2 + hstepB, voffB); PG8_STAGE(PG8_SA(0, 0), a2, voffA);
            PG8_WAIT_V8R(after_epi); PG8_WAIT_L(0); PG8_BAR; PG8_MMA(1, 0, At, B0); PG8_MMA(1, 1, At, B1); PG8_BAR; PG8_SCHED;
#endif
            PG8_LDB(B0, 1, 0); PG8_LDB(B1, 1, 1); PG8_SCHED; PG8_LDA(At, 1, 0); PG8_STAGE(PG8_SA(0, 1), a2 + hstep, voffA);
            PG8_WAIT_V(8); PG8_WAIT_L(0); PG8_BAR; PG8_MMA(0, 0, At, B0); PG8_MMA(0, 1, At, B1); PG8_BAR; PG8_SCHED;
#if PG8_LATE == 2
            PG8_LDA(At, 1, 1); PG8_STAGE(PG8_SB(1, 0), b3, voffB);
            PG8_WAIT_V(4); PG8_WAIT_L(0); PG8_BAR; PG8_MMA(1, 0, At, B0); PG8_SCHED; PG8_STAGE(PG8_SB(1, 1), b3 + hstepB, voffB); PG8_STAGE(PG8_SA(1, 0), a3, voffA); PG8_SCHED; PG8_MMA(1, 1, At, B1); PG8_BAR; PG8_SCHED;
#elif PG8_LATE == 1
            PG8_LDA(At, 1, 1); PG8_STAGE(PG8_SB(1, 0), b3, voffB); PG8_STAGE(PG8_SB(1, 1), b3 + hstepB, voffB);
            PG8_WAIT_V(6); PG8_WAIT_L(0); PG8_BAR; PG8_MMA(1, 0, At, B0); PG8_SCHED; PG8_STAGE(PG8_SA(1, 0), a3, voffA); PG8_SCHED; PG8_MMA(1, 1, At, B1); PG8_BAR; PG8_SCHED;
#else
            PG8_LDA(At, 1, 1); PG8_STAGE(PG8_SB(1, 0), b3, voffB); PG8_STAGE(PG8_SB(1, 1), b3 + hstepB, voffB); PG8_STAGE(PG8_SA(1, 0), a3, voffA);
            PG8_WAIT_V(8); PG8_WAIT_L(0); PG8_BAR; PG8_MMA(1, 0, At, B0); PG8_MMA(1, 1, At, B1); PG8_BAR; PG8_SCHED;
#endif
            } else {
            PG8_LDB(B0, 0, 0); PG8_SCHED; PG8_LDA(At, 0, 0); PG8_STAGE(PG8_SA(1, 1), a1 + hstep, voffA);
            PG8_WAIT_L(8); PG8_BAR; PG8_WAIT_L(0); PG8_MMA(0, 0, At, B0); PG8_BAR; PG8_SCHED;
            PG8_LDB(B1, 0, 1); PG8_STAGE(PG8_SB(0, 0), b2, voffB);
            PG8_BAR; PG8_WAIT_L(0); PG8_MMA(0, 1, At, B1); PG8_BAR;
            PG8_LDA(At, 0, 1); PG8_STAGE(PG8_SA(0, 0), a2, voffA);
            PG8_BAR; PG8_WAIT_L(0); PG8_MMA(1, 0, At, B0); PG8_BAR; PG8_SCHED;
            PG8_STAGE(PG8_SB(0, 1), b2 + hstepB, voffB);
            PG8_WAIT_V(6); PG8_BAR; PG8_MMA(1, 1, At, B1); PG8_BAR;
            PG8_LDB(B0, 1, 0); PG8_SCHED; PG8_LDA(At, 1, 0); PG8_STAGE(PG8_SA(0, 1), a2 + hstep, voffA);
            PG8_WAIT_L(8); PG8_BAR; PG8_WAIT_L(0); PG8_MMA(0, 0, At, B0); PG8_BAR; PG8_SCHED;
            PG8_LDB(B1, 1, 1); PG8_STAGE(PG8_SB(1, 0), b3, voffB);
            PG8_BAR; PG8_WAIT_L(0); PG8_MMA(0, 1, At, B1); PG8_BAR;
            PG8_LDA(At, 1, 1); PG8_STAGE(PG8_SA(1, 0), a3, voffA);
            PG8_BAR; PG8_WAIT_L(0); PG8_MMA(1, 0, At, B0); PG8_BAR; PG8_SCHED;
            PG8_STAGE(PG8_SB(1, 1), b3 + hstepB, voffB);
            PG8_WAIT_V(6); PG8_BAR; PG8_MMA(1, 1, At, B1); PG8_BAR;
            }
        }
        if constexpr (ALIGN_EPI) { if (wr == 0) PG8_BAR; }
        if constexpr (!Epi::AFTER_DRAIN) { E(acc, cur, wr, wc, fr, fq); S.done(cur); }
        if (!has_next) break;
#pragma unroll
        for (int a = 0; a < 2; ++a)
#pragma unroll
            for (int b = 0; b < 2; ++b)
#pragma unroll
                for (int m = 0; m < 4; ++m)
#pragma unroll
                    for (int n = 0; n < 2; ++n) acc[a][b][m][n] = (f32x4){0.f, 0.f, 0.f, 0.f};
        cur = nxt; cA = nA; cB = nB; ++ui;
        if constexpr (ALIGN_EPI) { if (wr == 1) PG8_BAR; }
    }
    PG8_WAIT_V(0);
    if constexpr (!ALIGN_EPI) { if (wr == 0) PG8_BAR; }
    PG8_BAR;
    if constexpr (Epi::AFTER_DRAIN) { E.fused(acc, cur, wr, wc, fr, fq, lds, wid, lane); S.done(cur); }
#undef PG8_SA
#undef PG8_SB
#undef PG8_STAGE
#undef PG8_LDA
#undef PG8_LDB
#undef PG8_MMA
#undef PG8_WAIT_V
#undef PG8_WAIT_V8R
#undef PG8_WAIT_L
#undef PG8_BAR
#undef PG8_SCHED
}
}

#define XB_TMO      128
#define XB_XCNT(j)  (256  + 64 * (j))
#define XB_XSUB(j)  (1280 + 64 * (j))
#define XB_XGEN(j)  (2304 + 64 * (j))
#define XB_TOP      3328
#define XB_TOPGEN   3392
#define XCD_BAR_WORDS 3456
#define XB_SPIN_CAP (1u << 18)

__device__ __forceinline__ unsigned xb_ld(unsigned* p)              { return __hip_atomic_load(p, __ATOMIC_RELAXED, __HIP_MEMORY_SCOPE_AGENT); }
__device__ __forceinline__ unsigned xb_add(unsigned* p, unsigned v) { return __hip_atomic_fetch_add(p, v, __ATOMIC_RELAXED, __HIP_MEMORY_SCOPE_AGENT); }
__device__ __forceinline__ unsigned xb_xcc_id() { return (unsigned)__builtin_amdgcn_s_getreg((3 << 11) | 20) & 0xFu; }
#define XB_SPIN(cond, bar) do { unsigned _sp = 0; while (cond) { __builtin_amdgcn_s_sleep(1); \
    if ((++_sp & 255u) == 0u) { if (xb_ld(&(bar)[XB_TMO])) break; if (_sp > XB_SPIN_CAP) { atomicAdd(&(bar)[XB_TMO], 1u); break; } } } } while (0)

struct XcdBarrier {
    unsigned* bar; unsigned x;
    volatile LAS unsigned* st;
};

__device__ __forceinline__ XcdBarrier xcd_barrier_post(unsigned* bar, volatile LAS unsigned* st) {
    XcdBarrier b; b.bar = bar; b.x = xb_xcc_id(); b.st = st;
    if (threadIdx.x == 0) (void)xb_add(&bar[XB_XCNT(b.x)], 1u);
    return b;
}
__device__ __forceinline__ void xcd_barrier_complete(unsigned* bar, unsigned x, unsigned& nloc, unsigned& nx) {
    const unsigned G = gridDim.x * gridDim.y * gridDim.z;
    unsigned sum, cnt, mine, sp = 0u;
    for (;;) {
        sum = 0u; cnt = 0u; mine = 0u;
#pragma unroll
        for (unsigned j = 0; j < 16; ++j) { const unsigned c = xb_ld(&bar[XB_XCNT(j)]); sum += c; cnt += (c > 0u) ? 1u : 0u; mine = (j == x) ? c : mine; }
        if (sum == G) break;
        __builtin_amdgcn_s_sleep(1);
        if ((++sp & 255u) == 0u) { if (xb_ld(&bar[XB_TMO])) break; if (sp > XB_SPIN_CAP) { atomicAdd(&bar[XB_TMO], 1u); break; } }
    }
    nloc = mine > 0u ? mine : 1u; nx = cnt > 0u ? cnt : 1u;
}

__device__ __forceinline__ void xcd_barrier(const XcdBarrier& b) {
    asm volatile("s_waitcnt vmcnt(0)" ::: "memory");
    __syncthreads();
    if (threadIdx.x == 0) {
        unsigned* bar = b.bar;
        __builtin_amdgcn_s_waitcnt(0);
        unsigned nloc = b.st[0], nx = b.st[1];
        if (nloc == 0u) { xcd_barrier_complete(bar, b.x, nloc, nx); b.st[0] = nloc; b.st[1] = nx; }
        const unsigned old = xb_add(&bar[XB_XSUB(b.x)], 1u);
        const unsigned gen = old / nloc;
        if (old + 1u == (gen + 1u) * nloc) {
            __builtin_amdgcn_fence(__ATOMIC_RELEASE, "agent");
            asm volatile("s_waitcnt vmcnt(0)" ::: "memory");
            const unsigned og = xb_add(&bar[XB_TOP], 1u);
            const unsigned tg = og / nx;
            if (og + 1u == (tg + 1u) * nx) xb_add(&bar[XB_TOPGEN], 1u);
            else XB_SPIN(xb_ld(&bar[XB_TOPGEN]) == tg, bar);
            __builtin_amdgcn_fence(__ATOMIC_ACQUIRE, "agent");
            xb_add(&bar[XB_XGEN(b.x)], 1u);
            asm volatile("s_waitcnt vmcnt(0)" ::: "memory");
        } else {
            XB_SPIN(xb_ld(&bar[XB_XGEN(b.x)]) == gen, bar);
            __builtin_amdgcn_fence(__ATOMIC_ACQUIRE, "agent");
            asm volatile("s_waitcnt vmcnt(0)" ::: "memory");
        }
    }
    __syncthreads();
}

namespace att {
typedef unsigned short bf16_t;
typedef short bf16x8 __attribute__((ext_vector_type(8)));
typedef short s16x4 __attribute__((ext_vector_type(4)));
typedef float f32x16 __attribute__((ext_vector_type(16)));
typedef float f32x4 __attribute__((ext_vector_type(4)));
typedef unsigned u32x4 __attribute__((ext_vector_type(4)));
typedef LAS unsigned char lds_u8;
#define SBAR() __builtin_amdgcn_sched_barrier(0)
__device__ __forceinline__ int kswz128(int row, int colB) { return row * 256 + (colB ^ ((row & 7) << 4)); }
__device__ __forceinline__ int kswz64(int row, int colB) { return row * 128 + (colB ^ ((row & 7) << 4)); }
__device__ __forceinline__ int v_st128(int k, int c) { const int kk = (k & ~0xC) | ((k & 4) << 1) | ((k & 8) >> 1); return ((kk >> 3) * 4 + (c >> 5)) * 512 + ((kk & 7) * 32 + (c & 31)) * 2; }
__device__ __forceinline__ int v_st64(int k, int c) { const int kk = (k & ~0xC) | ((k & 4) << 1) | ((k & 8) >> 1); return ((kk >> 3) * 2 + (c >> 5)) * 512 + ((kk & 7) * 32 + (c & 31)) * 2; }
__device__ __forceinline__ int v_rd_base(int lane) { return ((lane & 3) << 3) | (((lane >> 2) & 3) << 6) | (((lane >> 4) & 1) << 5) | (((lane >> 5) & 1) << 8); }
__device__ __forceinline__ unsigned cvtpk(float lo, float hi) { unsigned r; asm volatile("v_cvt_pk_bf16_f32 %0, %1, %2" : "=v"(r) : "v"(lo), "v"(hi)); return r; }
__device__ __forceinline__ float bf2f(short b) { return __uint_as_float(((unsigned)(unsigned short)b) << 16); }
__device__ __forceinline__ unsigned lds_addr(const lds_u8* p) { return (unsigned)(uintptr_t)p; }

template <int D> __device__ __forceinline__ void qkt(f32x16& p0, f32x16& p1, const lds_u8* Kt, int r32, int hi, const bf16x8* qr) {
    p0 = f32x16{}; p1 = f32x16{};
    if constexpr (D == 128) {
        const lds_u8* kb[4];
#pragma unroll
        for (int dd = 0; dd < 4; ++dd) kb[dd] = Kt + kswz128(r32, (dd * 16 + hi * 8) * 2);
#pragma unroll
        for (int d0 = 0; d0 < 8; ++d0) { const lds_u8* a = kb[d0 & 3] + (d0 >> 2) * 128;
            const bf16x8 b0 = *(const LAS bf16x8*)a, b1 = *(const LAS bf16x8*)(a + 32 * 256);
            p0 = __builtin_amdgcn_mfma_f32_32x32x16_bf16(b0, qr[d0], p0, 0, 0, 0);
            p1 = __builtin_amdgcn_mfma_f32_32x32x16_bf16(b1, qr[d0], p1, 0, 0, 0); }
    } else {
#pragma unroll
        for (int d0 = 0; d0 < 4; ++d0) { const lds_u8* a = Kt + kswz64(r32, (d0 * 16 + hi * 8) * 2);
            const bf16x8 b0 = *(const LAS bf16x8*)a, b1 = *(const LAS bf16x8*)(a + 32 * 128);
            p0 = __builtin_amdgcn_mfma_f32_32x32x16_bf16(b0, qr[d0], p0, 0, 0, 0);
            p1 = __builtin_amdgcn_mfma_f32_32x32x16_bf16(b1, qr[d0], p1, 0, 0, 0); }
    }
}
#define ATT_TRRD(dst, off) asm volatile("ds_read_b64_tr_b16 %0, %1 offset:%2" : "=&v"(dst) : "v"(vb), "i"(off) : "memory")
template <int D> __device__ __forceinline__ void pv_tile(f32x16* o, unsigned vb, bf16x8 pa0, bf16x8 pa1, bf16x8 pa2, bf16x8 pa3) {
    constexpr int KS = (D == 128) ? 4096 : 2048, HS = KS / 2;
#define ATT_PV_D0(d0) do { s16x4 l0, l1, l2, l3, h0, h1, h2, h3; constexpr int b_ = (d0) * 512;                                                   \
        ATT_TRRD(l0, b_); ATT_TRRD(h0, b_ + HS); ATT_TRRD(l1, b_ + KS); ATT_TRRD(h1, b_ + KS + HS); ATT_TRRD(l2, b_ + 2 * KS); ATT_TRRD(h2, b_ + 2 * KS + HS); \
        ATT_TRRD(l3, b_ + 3 * KS); ATT_TRRD(h3, b_ + 3 * KS + HS);                                                                                   \
        asm volatile("s_waitcnt lgkmcnt(0)" ::: "memory"); SBAR();                                                                                  \
        o[d0] = __builtin_amdgcn_mfma_f32_32x32x16_bf16(pa0, (bf16x8){l0[0], l0[1], l0[2], l0[3], h0[0], h0[1], h0[2], h0[3]}, o[d0], 0, 0, 0);   \
        o[d0] = __builtin_amdgcn_mfma_f32_32x32x16_bf16(pa1, (bf16x8){l1[0], l1[1], l1[2], l1[3], h1[0], h1[1], h1[2], h1[3]}, o[d0], 0, 0, 0);   \
        o[d0] = __builtin_amdgcn_mfma_f32_32x32x16_bf16(pa2, (bf16x8){l2[0], l2[1], l2[2], l2[3], h2[0], h2[1], h2[2], h2[3]}, o[d0], 0, 0, 0);   \
        o[d0] = __builtin_amdgcn_mfma_f32_32x32x16_bf16(pa3, (bf16x8){l3[0], l3[1], l3[2], l3[3], h3[0], h3[1], h3[2], h3[3]}, o[d0], 0, 0, 0); } while (0)
    ATT_PV_D0(0); ATT_PV_D0(1);
    if constexpr (D == 128) { ATT_PV_D0(2); ATT_PV_D0(3); }
#undef ATT_PV_D0
}
__device__ __forceinline__ void pack_p(const f32x16& p0, const f32x16& p1, bf16x8& pa0, bf16x8& pa1, bf16x8& pa2, bf16x8& pa3) {
#define ATT_PK4(P, B_, OUT) do { unsigned a0 = cvtpk(P[B_+0], P[B_+1]), a1 = cvtpk(P[B_+2], P[B_+3]);                          \
        unsigned b0 = cvtpk(P[B_+4], P[B_+5]), b1 = cvtpk(P[B_+6], P[B_+7]);                                             \
        auto r0 = __builtin_amdgcn_permlane32_swap(a0, b0, false, false); auto r1 = __builtin_amdgcn_permlane32_swap(a1, b1, false, false); \
        u32x4 w = {r0[0], r1[0], r0[1], r1[1]}; OUT = *reinterpret_cast<bf16x8*>(&w); } while (0)
    ATT_PK4(p0, 0, pa0); ATT_PK4(p0, 8, pa1); ATT_PK4(p1, 0, pa2); ATT_PK4(p1, 8, pa3);
#undef ATT_PK4
}
__device__ __forceinline__ float half_max(float v) { auto rr = __builtin_amdgcn_permlane32_swap(__float_as_uint(v), __float_as_uint(v), false, false); return fmaxf(__uint_as_float(rr[0]), __uint_as_float(rr[1])); }
__device__ __forceinline__ float half_sum(float v) { auto rr = __builtin_amdgcn_permlane32_swap(__float_as_uint(v), __float_as_uint(v), false, false); return __uint_as_float(rr[0]) + __uint_as_float(rr[1]); }
template <int D> __device__ __forceinline__ void store_o(const f32x16* o, bf16_t* O, int ldo, lds_u8* stg, int lane) {
    constexpr int PITCH = 2 * D + 16; const int r32 = lane & 31, hi = lane >> 5;
#pragma unroll
    for (int d0 = 0; d0 < D / 32; ++d0)
#pragma unroll
        for (int r = 0; r < 16; r += 2) { const unsigned w = cvtpk(o[d0][r], o[d0][r + 1]); const int row = (r & 3) + 8 * (r >> 2) + 4 * hi;
            lds_u8* p = stg + row * PITCH + (d0 * 32 + r32) * 2;
            *(LAS unsigned short*)p = (unsigned short)w; *(LAS unsigned short*)(p + PITCH) = (unsigned short)(w >> 16); }
    asm volatile("s_waitcnt lgkmcnt(0)" ::: "memory");
    constexpr int CPR = D / 8;
#pragma unroll
    for (int i = 0; i < 32 * CPR / 64; ++i) { const int ch = lane + 64 * i, row = ch / CPR, cc = ch % CPR;
        const u32x4 v = *(const LAS u32x4*)(stg + row * PITCH + cc * 16);
        *(u32x4*)(O + (size_t)row * ldo + cc * 8) = v; }
}

__device__ __forceinline__ void sb_half(f32x16& z, float& C, float m0) {
    float base = C;
#pragma unroll
    for (int g = 3; g >= 0; --g) {
        float zz[4], sp[4];
#pragma unroll
        for (int j = 0; j < 4; ++j) { zz[j] = fminf(z[4 * g + j], 120.f); sp[j] = __builtin_amdgcn_logf(1.0f + __builtin_amdgcn_exp2f(zz[j])); }
        const float s3 = sp[3], s2 = sp[2] + s3, s1 = sp[1] + s2, s0 = sp[0] + s1;
        auto rr = __builtin_amdgcn_permlane32_swap(__float_as_uint(s0), __float_as_uint(s0), false, false);
        const float lo = __uint_as_float(rr[0]), hv = __uint_as_float(rr[1]);
        const float b = fmaf(m0, hv, base);
        z[4 * g + 3] = __builtin_amdgcn_exp2f(zz[3] - (b + s3)); z[4 * g + 2] = __builtin_amdgcn_exp2f(zz[2] - (b + s2));
        z[4 * g + 1] = __builtin_amdgcn_exp2f(zz[1] - (b + s1)); z[4 * g + 0] = __builtin_amdgcn_exp2f(zz[0] - (b + s0));
        base += lo + hv;
    }
    C = base;
}

__device__ __forceinline__ void sb_unit(lds_u8* lds, volatile LAS int* flags, const bf16_t* __restrict__ P, int ldp, int qc, int kc, int vc, bf16_t* __restrict__ MIX, int b, int h, int qb) {
    const int tid = threadIdx.x, wid = __builtin_amdgcn_readfirstlane(tid >> 6), lane = tid & 63, r32 = lane & 31, hi = lane >> 5;
    const int q0 = qb * 256, rowbase = b * SEQ, qlo = q0 + 32 * wid, qpos = qlo + r32, d0 = q0 / 64, dw = d0 + (wid >> 1);
    const float m0 = hi ? 0.f : 1.f;
    bf16x8 qr[8];
    { const bf16_t* qp = P + (size_t)(rowbase + qpos) * ldp + qc + h * 128 + hi * 8;
#pragma unroll
      for (int d = 0; d < 8; ++d) qr[d] = *(const bf16x8*)(qp + d * 16); }
    f32x16 o[4] = {}; float C = 0.f; bool done = false;
    const int sr = tid >> 4, sc = (tid & 15) * 8;
    const bf16_t* Kg = P + (size_t)rowbase * ldp + kc + h * 128 + sc; const bf16_t* Vg = P + (size_t)rowbase * ldp + vc + h * 128 + sc;
    const int kw = kswz128(sr, sc * 2), vw0 = 16384 + v_st128(sr, sc), vw1 = 16384 + v_st128(32 + sr, sc);
    { bf16x8 kk[4][2], vv[4][2];
#pragma unroll
      for (int t = 0; t < 4; ++t) { const size_t r0 = (size_t)((d0 + t) * 64 + sr) * ldp, r1 = r0 + (size_t)32 * ldp;
          kk[t][0] = *(const bf16x8*)(Kg + r0); kk[t][1] = *(const bf16x8*)(Kg + r1); vv[t][0] = *(const bf16x8*)(Vg + r0); vv[t][1] = *(const bf16x8*)(Vg + r1); }
#pragma unroll
      for (int t = 0; t < 4; ++t) { lds_u8* sl = lds + ((d0 + t) & 3) * 32768;
          *(LAS bf16x8*)(sl + kw) = kk[t][0]; *(LAS bf16x8*)(sl + kw + 32 * 256) = kk[t][1]; *(LAS bf16x8*)(sl + vw0) = vv[t][0]; *(LAS bf16x8*)(sl + vw1) = vv[t][1]; } }
    if (lane == 0) flags[wid] = 0;
    __syncthreads();
    for (int s = 0;; ++s) {
        const int jn = d0 - s - 1;
        bf16x8 k0, k1, v0, v1;
        if (jn >= 0) { const size_t r0 = (size_t)(jn * 64 + sr) * ldp, r1 = r0 + (size_t)32 * ldp;
            k0 = *(const bf16x8*)(Kg + r0); k1 = *(const bf16x8*)(Kg + r1); v0 = *(const bf16x8*)(Vg + r0); v1 = *(const bf16x8*)(Vg + r1); }
        const int j = dw - s;
        if (j >= 0 && !done) {
            const lds_u8* Kt = lds + (j & 3) * 32768;
            f32x16 p0, p1; qkt<128>(p0, p1, Kt, r32, hi, qr);
            if (s == 0) {
                const int lim = qpos - j * 64 - 4 * hi; const float NEG = -__builtin_inff();
#pragma unroll
                for (int r = 0; r < 16; ++r) { const int c = (r & 3) + 8 * (r >> 2); if (c >= lim) p0[r] = NEG; if (c + 32 >= lim) p1[r] = NEG; }
            }
            sb_half(p1, C, m0); sb_half(p0, C, m0);
            bf16x8 pa0, pa1, pa2, pa3; pack_p(p0, p1, pa0, pa1, pa2, pa3);
            pv_tile<128>(o, lds_addr(Kt + 16384) + v_rd_base(lane), pa0, pa1, pa2, pa3);
            done = __all(C > 151.f);
        }
        if ((done || j <= 0) && lane == 0) flags[wid] = 1;
        __syncthreads();
        { int all = 1;
#pragma unroll
          for (int w = 0; w < 8; ++w) all &= flags[w];
          if (all) break; }
        if (jn >= 0) { lds_u8* sl = lds + (jn & 3) * 32768;
            *(LAS bf16x8*)(sl + kw) = k0; *(LAS bf16x8*)(sl + kw + 32 * 256) = k1; *(LAS bf16x8*)(sl + vw0) = v0; *(LAS bf16x8*)(sl + vw1) = v1; }
        __syncthreads();
    }
    store_o<128>(o, MIX + (size_t)(rowbase + qlo) * D_MODEL + h * 128, D_MODEL, lds + wid * 8704, lane);
    __syncthreads();
}

__device__ __forceinline__ void mem_unit(lds_u8* lds, const bf16_t* __restrict__ P, int ldp, int qmc, const bf16_t* __restrict__ KV, const float* __restrict__ gq, const float* __restrict__ gk,
                                         bf16_t* __restrict__ MIX, int b, int mh, int qb) {
    const int tid = threadIdx.x, wid = __builtin_amdgcn_readfirstlane(tid >> 6), lane = tid & 63, r32 = lane & 31, hi = lane >> 5;
    const int row = b * SEQ + qb * 256 + 32 * wid;
    const int sr = tid >> 4, sc = (tid & 15) * 8;
    constexpr float SCL = 0.08838834764831845f * 1.4426950408889634f;
    float gg[8];
#pragma unroll
    for (int j = 0; j < 8; ++j) gg[j] = gq[sc + j] * gk[sc + j] * SCL;
#pragma unroll
    for (int t = 0; t < 4; ++t)
#pragma unroll
        for (int hh = 0; hh < 2; ++hh) { const int key = t * 64 + hh * 32 + sr; const bf16_t* kp = KV + (size_t)(b * MEM_LEN + key) * (2 * MEM_W) + mh * 128 + sc;
            const bf16x8 kr = *(const bf16x8*)kp, vr = *(const bf16x8*)(kp + MEM_W);
            float kf[8], ss = 0.f;
#pragma unroll
            for (int j = 0; j < 8; ++j) { kf[j] = bf2f(kr[j]); ss += kf[j] * kf[j]; }
            ss += __shfl_xor(ss, 1); ss += __shfl_xor(ss, 2); ss += __shfl_xor(ss, 4); ss += __shfl_xor(ss, 8);
            const float rs = __builtin_amdgcn_rsqf(ss * (1.0f / 128.0f) + NORM_EPS);
            u32x4 w; w.x = cvtpk(kf[0] * rs * gg[0], kf[1] * rs * gg[1]); w.y = cvtpk(kf[2] * rs * gg[2], kf[3] * rs * gg[3]);
            w.z = cvtpk(kf[4] * rs * gg[4], kf[5] * rs * gg[5]); w.w = cvtpk(kf[6] * rs * gg[6], kf[7] * rs * gg[7]);
            *(LAS u32x4*)(lds + t * 32768 + kswz128(hh * 32 + sr, sc * 2)) = w;
            *(LAS bf16x8*)(lds + t * 32768 + 16384 + v_st128(hh * 32 + sr, sc)) = vr; }
    bf16x8 qr[8]; float ssq = 0.f;
    { const bf16_t* qp = P + (size_t)(row + r32) * ldp + qmc + mh * 128 + hi * 8;
#pragma unroll
      for (int d0 = 0; d0 < 8; ++d0) { qr[d0] = *(const bf16x8*)(qp + d0 * 16);
#pragma unroll
          for (int j = 0; j < 8; ++j) { const float f = bf2f(qr[d0][j]); ssq += f * f; } } }
    ssq = half_sum(ssq);
    const float rq = __builtin_amdgcn_rsqf(ssq * (1.0f / 128.0f) + NORM_EPS);
    __syncthreads();
    float m = -1e30f, l = 0.f;
#pragma unroll 1
    for (int t = 0; t < 4; ++t) { f32x16 p0, p1; qkt<128>(p0, p1, lds + t * 32768, r32, hi, qr);
        float tm = -1e30f;
#pragma unroll
        for (int r = 0; r < 16; ++r) { p0[r] *= rq; p1[r] *= rq; tm = fmaxf(tm, fmaxf(p0[r], p1[r])); }
        tm = half_max(tm); const float mn = fmaxf(m, tm); float ps = 0.f;
#pragma unroll
        for (int r = 0; r < 16; ++r) ps += __builtin_amdgcn_exp2f(p0[r] - mn) + __builtin_amdgcn_exp2f(p1[r] - mn);
        ps = half_sum(ps); l = l * __builtin_amdgcn_exp2f(m - mn) + ps; m = mn; }
    const float nl = -(m + __builtin_amdgcn_logf(l));
    f32x16 o[4] = {};
#pragma unroll 1
    for (int t = 0; t < 4; ++t) { f32x16 p0, p1; qkt<128>(p0, p1, lds + t * 32768, r32, hi, qr);
#pragma unroll
        for (int r = 0; r < 16; ++r) { p0[r] = __builtin_amdgcn_exp2f(fmaf(p0[r], rq, nl)); p1[r] = __builtin_amdgcn_exp2f(fmaf(p1[r], rq, nl)); }
        bf16x8 pa0, pa1, pa2, pa3; pack_p(p0, p1, pa0, pa1, pa2, pa3);
        pv_tile<128>(o, lds_addr(lds + t * 32768 + 16384) + v_rd_base(lane), pa0, pa1, pa2, pa3); }
    __syncthreads();
    store_o<128>(o, MIX + (size_t)row * D_MODEL + TOK_W + mh * 128, D_MODEL, lds + wid * 8704, lane);
    __syncthreads();
}

__device__ __forceinline__ void swa_unit(lds_u8* lds, const bf16_t* __restrict__ P, int ldp, const float* __restrict__ sinks, bf16_t* __restrict__ MIX, int b, int kvh, int qi) {
    const int tid = threadIdx.x, wid = __builtin_amdgcn_readfirstlane(tid >> 6), lane = tid & 63, r32 = lane & 31, hi = lane >> 5;
    const int q0 = qi * 64, rowbase = b * SEQ, hq = kvh * SWA_GROUP + wid;
    const int sr = tid >> 3, sc = (tid & 7) * 8;
    bf16x8 qra[2][4];
#pragma unroll
    for (int rt = 0; rt < 2; ++rt) { const bf16_t* qp = P + (size_t)(rowbase + q0 + 32 * rt + r32) * ldp + hq * 64 + hi * 8;
#pragma unroll
        for (int d0 = 0; d0 < 4; ++d0) qra[rt][d0] = *(const bf16x8*)(qp + d0 * 16); }
#pragma unroll
    for (int t = 0; t < 3; ++t) { const int kb = q0 - 128 + 64 * t;
        if (kb >= 0) { const bf16_t* kp = P + (size_t)(rowbase + kb + sr) * ldp + TOK_W + kvh * 64 + sc;
            const bf16x8 kr = *(const bf16x8*)kp, vr = *(const bf16x8*)(kp + SWA_KV_HEADS * SWA_HD);
            *(LAS bf16x8*)(lds + t * 16384 + kswz64(sr, sc * 2)) = kr; *(LAS bf16x8*)(lds + t * 16384 + 8192 + v_st64(sr, sc)) = vr; } }
    const float sink2 = sinks[hq] * 1.4426950408889634f;
    __syncthreads();
#pragma unroll
    for (int rt = 0; rt < 2; ++rt) {
        const int qlo = q0 + 32 * rt, qpos = qlo + r32;
        const bf16x8* qr = qra[rt];
        f32x16 p[3][2]; const float NEG = -__builtin_inff();
#pragma unroll
        for (int t = 0; t < 3; ++t) { const int kb = q0 - 128 + 64 * t;
            if (kb >= 0) { qkt<64>(p[t][0], p[t][1], lds + t * 16384, r32, hi, qr);
                const int dq = qpos - kb - 4 * hi;
#pragma unroll
                for (int r = 0; r < 16; ++r) { const int c = (r & 3) + 8 * (r >> 2);
                    if ((unsigned)(dq - c) >= (unsigned)WINDOW) p[t][0][r] = NEG;
                    if ((unsigned)(dq - c - 32) >= (unsigned)WINDOW) p[t][1][r] = NEG; } }
            else {
#pragma unroll
                for (int r = 0; r < 16; ++r) { p[t][0][r] = NEG; p[t][1][r] = NEG; } } }
        float m = sink2;
#pragma unroll
        for (int t = 0; t < 3; ++t)
#pragma unroll
            for (int r = 0; r < 16; ++r) m = fmaxf(m, fmaxf(p[t][0][r], p[t][1][r]));
        m = half_max(m);
        float ps = 0.f;
#pragma unroll
        for (int t = 0; t < 3; ++t)
#pragma unroll
            for (int r = 0; r < 16; ++r) { p[t][0][r] = __builtin_amdgcn_exp2f(p[t][0][r] - m); p[t][1][r] = __builtin_amdgcn_exp2f(p[t][1][r] - m); ps += p[t][0][r] + p[t][1][r]; }
        ps = half_sum(ps);
        const float rl = __builtin_amdgcn_rcpf(ps + __builtin_amdgcn_exp2f(sink2 - m));
        f32x16 o[2] = {};
#pragma unroll
        for (int t = 0; t < 3; ++t) { const int kb = q0 - 128 + 64 * t;
            if (kb >= 0) {
#pragma unroll
                for (int r = 0; r < 16; ++r) { p[t][0][r] *= rl; p[t][1][r] *= rl; }
                bf16x8 pa0, pa1, pa2, pa3; pack_p(p[t][0], p[t][1], pa0, pa1, pa2, pa3);
                pv_tile<64>(o, lds_addr(lds + t * 16384 + 8192) + v_rd_base(lane), pa0, pa1, pa2, pa3); } }
        store_o<64>(o, MIX + (size_t)(rowbase + qlo) * D_MODEL + hq * 64, D_MODEL, lds + 49152 + wid * 4608, lane);
    }
    __syncthreads();
}
#undef ATT_TRRD
#undef SBAR
}

constexpr int NWAVES = 8;
#ifndef MK_SPLIT
#define MK_SPLIT 0
#endif
#ifndef PG8_ALIGN
#define PG8_ALIGN true
#endif
#ifndef PG8_SP2
#define PG8_SP2 true
#endif
#ifndef RES_WGM
#define RES_WGM 4
#endif
#ifndef DOWN_REV
#define DOWN_REV 1
#endif
#ifndef PROBE_GROUP
#define PROBE_GROUP 0
#endif
constexpr int REP_GU = PROBE_GROUP == 1 ? 2 : 1, REP_RS = PROBE_GROUP == 2 ? 2 : 1, REP_P0 = PROBE_GROUP == 3 ? 5 : 1, REP_AT = PROBE_GROUP == 4 ? 5 : 1, REP_PJ = PROBE_GROUP == 6 ? 2 : 1;
constexpr size_t MiB = 1u << 20;
constexpr size_t WS_CTL = 0, CTL_ZERO_BYTES = 1 * MiB;
constexpr size_t SZ_WGU = (size_t)2 * D_FF * D_MODEL * 2, SZ_WD = (size_t)D_MODEL * D_FF * 2;
constexpr int IN1_ROWS = 2560;
constexpr size_t WS_WGU = 1 * MiB;
constexpr size_t WS_WD = WS_WGU + 4 * SZ_WGU;
constexpr size_t WS_WIN0 = WS_WD + 4 * SZ_WD;
constexpr size_t WS_WIN1 = WS_WIN0 + (size_t)SB_IN_W * D_MODEL * 2;
constexpr size_t WS_WOUT = WS_WIN1 + (size_t)IN1_ROWS * D_MODEL * 2;
constexpr size_t WS_WMKV = WS_WOUT + 2 * (size_t)D_MODEL * D_MODEL * 2;
constexpr size_t WS_XB = WS_WMKV + 2 * (size_t)2 * MEM_W * D_MODEL * 2;
constexpr size_t WS_ACT = WS_XB + (size_t)M * D_MODEL * 2;
constexpr size_t WS_MIX = WS_ACT + (size_t)M * D_FF * 2;
constexpr size_t WS_MEMN = WS_MIX + (size_t)M * D_MODEL * 2;
constexpr size_t WS_KVM = WS_MEMN + 2 * (size_t)MROWS * D_MODEL * 2;
constexpr size_t WS_SS = WS_KVM + 2 * (size_t)MROWS * 2 * MEM_W * 2;
constexpr size_t WS_END = WS_SS + (size_t)M * 8 * 4;
static_assert(WS_WGU % 256 == 0 && WS_WD % 256 == 0 && WS_WIN0 % 256 == 0 && WS_WIN1 % 256 == 0 && WS_WOUT % 256 == 0 && WS_WMKV % 256 == 0 && WS_XB % 256 == 0 && WS_SS % 256 == 0 && WS_ACT % 256 == 0 &&
              WS_MIX % 256 == 0 && WS_MEMN % 256 == 0 && WS_KVM % 256 == 0, "ws alignment");
constexpr int CW_BAR = 4096;
constexpr int RING_BYTES = 131072;
constexpr int TAB_OFF = 131072;
constexpr int MISC_OFF = 135168, LDS_BYTES = 147456;
constexpr int NPHASE = 2 + 7 * DEPTH;

typedef unsigned short bf16;
typedef unsigned v4u __attribute__((ext_vector_type(4)));
typedef float f32x4 __attribute__((ext_vector_type(4)));
#define LDS_WAIT() asm volatile("s_waitcnt lgkmcnt(0)" ::: "memory")
__device__ __forceinline__ unsigned f2bf(float f) { unsigned u = __builtin_bit_cast(unsigned, f); return (u + 0x7fffu + ((u >> 16) & 1u)) >> 16; }
__device__ __forceinline__ unsigned pk2(float lo, float hi) { return f2bf(lo) | (f2bf(hi) << 16); }
__device__ __forceinline__ float wave_sum(float v) {
#pragma unroll
    for (int o = 1; o < 64; o <<= 1) v += __shfl_xor(v, o);
    return v;
}

struct Ptrs {
    const float *x_in, *mem, *ffn_g, *w_gate, *w_up, *w_down, *mix_g, *mem_g, *w_mkv, *memq_g, *memk_g, *w_out, *w_in0, *w_in1, *swa_qg, *swa_kg, *sinks;
    const int* pos;
    float* out;
    bf16 *WGU, *WD, *WIN0, *WIN1, *WOUT, *WMKV, *XB, *ACT, *MIX, *MEMN, *KVM;
    float* SS;
};

enum { K_PLAIN = 0, K_GU = 1, K_IN1 = 2 };
__device__ __forceinline__ int map_src(int kind, int n, int& sel) {
    sel = 0;
    if (kind == K_GU) { const int pn = n >> 8, p = n & 255; sel = p >> 7; return 128 * pn + (p & 127); }
    if (kind == K_IN1) { const int pn = n >> 8, p = n & 255, bj = p >> 7, wc = (p >> 5) & 3;
        if (pn < 6) return (4 * pn + wc) * 64 + 32 * bj;
        if (pn == 6) return wc < 3 ? TOK_W + wc * 64 + 32 * bj : -1;
        if (pn == 7) return p < 192 ? TOK_W + 192 + p : -1;
        return TOK_W + 384 + (pn - 8) * 256 + p; }
    return n;
}
struct CvtItem { const float* sp; const float* gp; bf16* dp; int Nsrc, flags; };
__device__ __forceinline__ CvtItem cvt_make(const float* src, const float* src2, const float* gain, int Nsrc, int K, bf16* dst, int kind, int n0, int k0, int lane) {
    const int f = lane & 15, hf = f >> 3, c4 = (f & 7) * 4; int sel; const int sc = map_src(kind, n0 + 32 * hf, sel);
    CvtItem I; I.sp = (sel ? src2 : src) + (size_t)(k0 + (lane >> 4)) * Nsrc + (sc < 0 ? 0 : sc) + c4; I.gp = gain ? gain + k0 + 8 * (lane & 7) : I.sp; I.Nsrc = Nsrc; I.flags = (sc < 0 ? 1 : 0) | (gain ? 2 : 0);
    I.dp = dst + (size_t)(n0 >> 8) * 256 * K + (size_t)(k0 >> 6) * (256 * 64) + ((n0 & 255) + (lane >> 3)) * 64 + 8 * (lane & 7); return I;
}
#define CVT_LD(dst, ptr) asm volatile("global_load_dwordx4 %0, %1, off nt" : "=v"(dst) : "v"(ptr))
__device__ __forceinline__ void cvt_load(const CvtItem& I, f32x4 (&v)[16], f32x4 (&g)[2]) {
    CVT_LD(g[0], (const f32x4*)I.gp); CVT_LD(g[1], (const f32x4*)(I.gp + 4));
#pragma unroll
    for (int i = 0; i < 16; ++i) CVT_LD(v[i], (const f32x4*)(I.sp + (size_t)(4 * i) * I.Nsrc));
}
template <int N> __device__ __forceinline__ void cvt_wait(f32x4 (&v)[16], f32x4 (&g)[2]) {
    asm volatile("s_waitcnt vmcnt(%9)" : "+v"(v[0]), "+v"(v[1]), "+v"(v[2]), "+v"(v[3]), "+v"(v[4]), "+v"(v[5]), "+v"(v[6]), "+v"(v[7]), "+v"(g[0]) : "n"(N) : "memory");
    asm volatile("" : "+v"(v[8]), "+v"(v[9]), "+v"(v[10]), "+v"(v[11]), "+v"(v[12]), "+v"(v[13]), "+v"(v[14]), "+v"(v[15]), "+v"(g[1]) :: "memory");
}
__device__ __forceinline__ unsigned cvt_pk(float lo, float hi) { unsigned r; asm volatile("v_cvt_pk_bf16_f32 %0, %1, %2" : "=v"(r) : "v"(lo), "v"(hi)); return r; }
__device__ __forceinline__ void cvt_store(const CvtItem& I, const f32x4 (&v)[16], const f32x4 (&g)[2], LAS float* scr, int lane) {
    const int f = lane & 15;
#pragma unroll
    for (int i = 0; i < 16; ++i) { const f32x4 w = (I.flags & 1) ? (f32x4){0.f, 0.f, 0.f, 0.f} : v[i];
        LAS float* d = scr + (4 * i + (lane >> 4)) * 65 + f * 4; d[0] = w[0]; d[1] = w[1]; d[2] = w[2]; d[3] = w[3]; }
    LDS_WAIT(); asm volatile("" ::: "memory");
    const int c = lane & 7;
    const f32x4 one = {1.f, 1.f, 1.f, 1.f}, ga = (I.flags & 2) ? g[0] : one, gb = (I.flags & 2) ? g[1] : one;
#pragma unroll
    for (int j = 0; j < 8; ++j) { const int n = 8 * j + (lane >> 3); const LAS float* s = scr + (8 * c) * 65 + n;
        v4u o; o.x = cvt_pk(s[0 * 65] * ga[0], s[1 * 65] * ga[1]); o.y = cvt_pk(s[2 * 65] * ga[2], s[3 * 65] * ga[3]);
        o.z = cvt_pk(s[4 * 65] * gb[0], s[5 * 65] * gb[1]); o.w = cvt_pk(s[6 * 65] * gb[2], s[7 * 65] * gb[3]);
        __builtin_nontemporal_store(o, (v4u*)(I.dp + (8 * j) * 64)); }
    LDS_WAIT(); asm volatile("" ::: "memory");
}
__device__ __forceinline__ void rms_row_to_bf16(const float* __restrict__ xrow, const float* __restrict__ g, bf16* __restrict__ orow, int lane) {
    const f32x4* xr = (const f32x4*)xrow + lane; const f32x4* gr = (const f32x4*)g + lane;
    f32x4 v[8]; float s = 0.f;
#pragma unroll
    for (int j = 0; j < 8; ++j) { v[j] = xr[64 * j]; s += (v[j].x * v[j].x + v[j].y * v[j].y) + (v[j].z * v[j].z + v[j].w * v[j].w); }
    const float rstd = 1.0f / sqrtf(wave_sum(s) * (1.0f / D_MODEL) + NORM_EPS);
    unsigned long long* o8 = (unsigned long long*)orow + lane;
#pragma unroll
    for (int j = 0; j < 8; ++j) { const f32x4 gv = gr[64 * j];
        o8[64 * j] = (unsigned long long)pk2(v[j].x * rstd * gv.x, v[j].y * rstd * gv.y) | ((unsigned long long)pk2(v[j].z * rstd * gv.z, v[j].w * rstd * gv.w) << 32); }
}
__device__ __forceinline__ void stream_rows_init(const float* __restrict__ x, bf16* __restrict__ XB, float* __restrict__ SS, int gw, int ngw, int lane) {
    int m = gw; if (m >= M) return;
    f32x4 v[8];
#pragma unroll
    for (int j = 0; j < 8; ++j) v[j] = __builtin_nontemporal_load((const f32x4*)(x + (size_t)m * D_MODEL) + lane + 64 * j);
    auto emit = [&](const f32x4 (&w)[8], int row) { float s = 0.f;
#pragma unroll
        for (int j = 0; j < 8; ++j) s += (w[j].x * w[j].x + w[j].y * w[j].y) + (w[j].z * w[j].z + w[j].w * w[j].w);
        s = wave_sum(s);
        unsigned long long* o8 = (unsigned long long*)(XB + (size_t)row * D_MODEL) + lane;
#pragma unroll
        for (int j = 0; j < 8; ++j) o8[64 * j] = (unsigned long long)pk2(w[j].x, w[j].y) | ((unsigned long long)pk2(w[j].z, w[j].w) << 32);
        if (lane < 2) *((f32x4*)(SS + (size_t)row * 8) + lane) = (f32x4){lane == 0 ? s : 0.f, 0.f, 0.f, 0.f}; };
    while (m + ngw < M) { const int nx = m + ngw; f32x4 vn[8];
#pragma unroll
        for (int j = 0; j < 8; ++j) vn[j] = __builtin_nontemporal_load((const f32x4*)(x + (size_t)nx * D_MODEL) + lane + 64 * j);
        emit(v, m); m = nx;
#pragma unroll
        for (int j = 0; j < 8; ++j) v[j] = vn[j]; }
    emit(v, m);
}
template <class Decode> __device__ __forceinline__ void cvt_run(const Decode& decode, int first, int stride, int last, LAS float* scr, int lane) {
    if (first >= last) return;
    auto item = [&](int it, const CvtItem& prev) -> CvtItem { if (it < last) return decode(it); CvtItem d = prev; d.Nsrc = 0; return d; };
    int it = first; CvtItem A = decode(it), B; f32x4 va[16], ga[2], vb[16], gb[2];
    cvt_load(A, va, ga); it += stride; B = item(it, A); cvt_load(B, vb, gb);
    cvt_wait<18>(va, ga); cvt_store(A, va, ga, scr, lane);
    while (it < last) {
        A = item(it + stride, B); cvt_load(A, va, ga);
        cvt_wait<26>(vb, gb); cvt_store(B, vb, gb, scr, lane); it += stride;
        if (it >= last) break;
        B = item(it + stride, A); cvt_load(B, vb, gb);
        cvt_wait<26>(va, ga); cvt_store(A, va, ga, scr, lane); it += stride;
    }
    asm volatile("s_waitcnt vmcnt(0)" ::: "memory");
}
__device__ __forceinline__ void p0a_prologue(const Ptrs& T, LAS unsigned char* lds, int gw, int ngw, int wave, int lane) {
    LAS float* scr = (LAS float*)(lds + wave * 16640);
    constexpr int I_MKV = (2 * MEM_W / 64) * (D_MODEL / 64);
    auto decode = [&](int it) -> CvtItem { const int l = it / I_MKV, r = it - l * I_MKV; constexpr int nb = 2 * MEM_W / 64;
        return cvt_make(T.w_mkv + (size_t)l * D_MODEL * 2 * MEM_W, T.w_mkv, nullptr, 2 * MEM_W, D_MODEL, T.WMKV + (size_t)l * 2 * MEM_W * D_MODEL, K_PLAIN, (r % nb) * 64, (r / nb) * 64, lane); };
    cvt_run(decode, gw, ngw, 2 * I_MKV, scr, lane);
    for (int m = gw; m < MROWS; m += ngw)
        for (int l = 0; l < DEPTH; ++l) rms_row_to_bf16(T.mem + (size_t)m * D_MODEL, T.mem_g + l * D_MODEL, T.MEMN + ((size_t)l * MROWS + m) * D_MODEL, lane);
    stream_rows_init(T.x_in, T.XB, T.SS, gw, ngw, lane);
}
constexpr int I_GU = (2 * D_FF / 64) * (D_MODEL / 64), I_WD = (D_MODEL / 64) * (D_FF / 64), I_IN0 = (SB_IN_W / 64) * (D_MODEL / 64), I_IN1 = (IN1_ROWS / 64) * (D_MODEL / 64), I_OUT = (D_MODEL / 64) * (D_MODEL / 64);
constexpr int I_GUE = 1664, I_GUL = I_GU - I_GUE;
constexpr int CVT_EARLY = 3 * I_GU + I_GUE + 3 * I_WD + I_IN0 + I_IN1 + I_OUT, CVT_ALL = CVT_EARLY + I_GUL + I_WD + I_OUT;
static_assert(CVT_ALL == 4 * I_GU + 4 * I_WD + I_IN0 + I_IN1 + 2 * I_OUT && I_GUE > 0 && I_GUL > 0, "item list");
__device__ __forceinline__ CvtItem cvt_decode(const Ptrs& T, int it, int lane) {
    int r = it; const float* src; const float* src2 = nullptr; const float* gain = nullptr; bf16* dst; int Nsrc, K, ndst, kind = K_PLAIN, f = -1;
    if (r < 3 * I_GU + I_GUE) { f = r / I_GU; r -= f * I_GU; }
    else if ((r -= 3 * I_GU + I_GUE) < 3 * I_WD) { const int fd = r / I_WD; r -= fd * I_WD; src = T.w_down + (size_t)fd * D_FF * D_MODEL; dst = T.WD + (size_t)fd * D_MODEL * D_FF; Nsrc = D_MODEL; K = D_FF; ndst = D_MODEL; }
    else if ((r -= 3 * I_WD) < I_IN0) { src = T.w_in0; gain = T.mix_g; dst = T.WIN0; Nsrc = SB_IN_W; K = D_MODEL; ndst = SB_IN_W; }
    else if ((r -= I_IN0) < I_IN1) { src = T.w_in1; gain = T.mix_g + D_MODEL; dst = T.WIN1; Nsrc = SWA_IN_W; K = D_MODEL; ndst = IN1_ROWS; kind = K_IN1; }
    else if ((r -= I_IN1) < I_OUT) { src = T.w_out; dst = T.WOUT; Nsrc = D_MODEL; K = D_MODEL; ndst = D_MODEL; }
    else if ((r -= I_OUT) < I_GUL) { f = 3; r += I_GUE; }
    else if ((r -= I_GUL) < I_WD) { src = T.w_down + (size_t)3 * D_FF * D_MODEL; dst = T.WD + (size_t)3 * D_MODEL * D_FF; Nsrc = D_MODEL; K = D_FF; ndst = D_MODEL; }
    else { r -= I_WD; src = T.w_out + (size_t)D_MODEL * D_MODEL; dst = T.WOUT + (size_t)D_MODEL * D_MODEL; Nsrc = D_MODEL; K = D_MODEL; ndst = D_MODEL; }
    if (f >= 0) { src = T.w_gate + (size_t)f * D_MODEL * D_FF; src2 = T.w_up + (size_t)f * D_MODEL * D_FF; gain = T.ffn_g + f * D_MODEL; dst = T.WGU + (size_t)f * 2 * D_FF * D_MODEL; Nsrc = D_FF; K = D_MODEL; ndst = 2 * D_FF; kind = K_GU; }
    const int nb = ndst / 64, n0 = (r % nb) * 64, k0 = (r / nb) * 64;
    return cvt_make(src, src2 ? src2 : src, gain, Nsrc, K, dst, kind, n0, k0, lane);
}
__device__ __forceinline__ void p0b_prologue(const Ptrs& T, LAS unsigned char* lds, int vcu, int G, int wave, int lane) {
    LAS float* scr = (LAS float*)(lds + wave * 16640);
    static_assert(DEPTH == 2, "item list written out for two layers");
    auto decode = [&](int it) -> CvtItem { return cvt_decode(T, it, lane); };
    if (G == 256) {
        constexpr int NA = 16 * NWAVES, SHARE_A = 9, SHARE_B = 16, NB = (256 - 16) * NWAVES, NITEMS = CVT_EARLY;
        static_assert(NA * SHARE_A + NB * SHARE_B == NITEMS, "conversion shares");
        const int w = vcu * NWAVES + wave;
        if (vcu < 16) {
            { pg8::Gemm g{T.MEMN, T.WMKV, MROWS, 2 * MEM_W, D_MODEL};
                pg8::StaticOrder S; S.init(MROWS, 2 * MEM_W, G, vcu);
                pg8::EpiBf16S E{T.KVM, 2 * MEM_W, 0, 1.f, nullptr, NORM_EPS, {}};
                pg8::gemm_phase<pg8::EpiBf16S, pg8::StaticOrder, PG8_ALIGN, PG8_SP2>(lds, g, S, E); }
            cvt_run(decode, w, NA, NA * SHARE_A, scr, lane);
        } else cvt_run(decode, NA * SHARE_A + (w - NA), NB, NITEMS, scr, lane);
    } else {
#pragma unroll
        for (int l = 0; l < DEPTH; ++l) { pg8::Gemm g{T.MEMN + (size_t)l * MROWS * D_MODEL, T.WMKV + (size_t)l * 2 * MEM_W * D_MODEL, MROWS, 2 * MEM_W, D_MODEL};
            pg8::StaticOrder S; S.init(MROWS, 2 * MEM_W, G, vcu);
            pg8::EpiBf16S E{T.KVM + (size_t)l * MROWS * 2 * MEM_W, 2 * MEM_W, 0, 1.f, nullptr, NORM_EPS, {}};
            pg8::gemm_phase<pg8::EpiBf16S, pg8::StaticOrder, PG8_ALIGN, PG8_SP2>(lds, g, S, E); }
        cvt_run(decode, vcu * NWAVES + wave, G * NWAVES, CVT_ALL, scr, lane);
    }
}

struct Args { const void* in[18]; float* out; unsigned char* ws; int ph_lo, ph_hi, li, pad; };
static_assert(sizeof(Args) == 18 * 8 + 8 + 8 + 16, "Args has no padding");
struct Ctx { Ptrs T; LAS unsigned char* lds; volatile LAS unsigned* MISC; XcdBarrier bar; int lo, hi, G, bx, vcu, gw, ngw, lane, wave; };
#define IN(k) (c.lo <= (k) && (k) < c.hi)
#define SEAM(k) do { if (IN(k) && IN((k) + 1)) xcd_barrier(c.bar); } while (0)
#define REPBAR() do { if (!MK_SPLIT) xcd_barrier(c.bar); } while (0)
#define RUN_PHASE(k, nrep, call0, call1) do { if (IN(k)) { call0; if constexpr ((nrep) >= 2) { REPBAR(); call1; } if constexpr ((nrep) >= 3) { REPBAR(); call1; } if constexpr ((nrep) >= 4) { REPBAR(); call1; } if constexpr ((nrep) >= 5) { REPBAR(); call1; } } } while (0)
template <int F> __device__ __forceinline__ void ph_up(const Ctx& c) {
    const Ptrs& T = c.T;
    pg8::Gemm g{T.XB, T.WGU + (size_t)F * 2 * D_FF * D_MODEL, M, 2 * D_FF, D_MODEL}; pg8::StaticOrder S; S.init(M, 2 * D_FF, c.G, c.bx);
    pg8::EpiSwiGLU E{T.ACT, D_FF, T.SS, NORM_EPS, {}};
    pg8::gemm_phase<pg8::EpiSwiGLU, pg8::StaticOrder, PG8_ALIGN, PG8_SP2>(c.lds, g, S, E);
}
template <int F, int R = 0> __device__ __forceinline__ void ph_down(const Ctx& c) {
    const Ptrs& T = c.T; pg8::Gemm g{T.ACT, T.WD + (size_t)F * D_MODEL * D_FF, M, D_MODEL, D_FF}; pg8::StaticOrder S; S.init(M, D_MODEL, c.G, c.bx, RES_WGM, DOWN_REV);
    constexpr bool FINAL = (F == 2 * DEPTH - 1);
    pg8::EpiResidB<FINAL> E{T.XB, T.out, T.SS, (LAS float*)(c.lds + TAB_OFF), D_MODEL, R == 0 ? 0.5f : 0.f};
    pg8::gemm_phase<pg8::EpiResidB<FINAL>, pg8::StaticOrder, true, PG8_SP2>(c.lds, g, S, E);
}
template <int L> __device__ __forceinline__ void ph_inproj(const Ctx& c) {
    const Ptrs& T = c.T;
    if constexpr (L % 2 == 0) { pg8::Gemm g{T.XB, T.WIN0, M, SB_IN_W, D_MODEL}; pg8::StaticOrder S; S.init(M, SB_IN_W, c.G, c.bx);
        pg8::EpiBf16S E{T.ACT, SB_IN_W, TOK_W / 256, 0.08838834764831845f * 1.4426950408889634f, T.SS, NORM_EPS, {}};
        pg8::gemm_phase<pg8::EpiBf16S, pg8::StaticOrder, PG8_ALIGN, PG8_SP2>(c.lds, g, S, E); }
    else { pg8::Gemm g{T.XB, T.WIN1, M, IN1_ROWS, D_MODEL}; pg8::StaticOrder S; S.init(M, IN1_ROWS, c.G, c.bx);
        pg8::EpiProjSWA E{T.ACT, IN1_ROWS, T.swa_qg, T.swa_kg, T.pos, 0.125f * 1.4426950408889634f, NORM_EPS, T.SS};
        pg8::gemm_phase<pg8::EpiProjSWA, pg8::StaticOrder, PG8_ALIGN, PG8_SP2>(c.lds, g, S, E);
        if (c.G == 256 && c.bx >= 128 && c.bx < 144) {
            pg8::Gemm gm{T.MEMN + (size_t)MROWS * D_MODEL, T.WMKV + (size_t)2 * MEM_W * D_MODEL, MROWS, 2 * MEM_W, D_MODEL}; pg8::StaticOrder Sm; Sm.init(MROWS, 2 * MEM_W, 16, c.bx - 128);
            pg8::EpiBf16S Em{T.KVM + (size_t)MROWS * 2 * MEM_W, 2 * MEM_W, 0, 1.f, nullptr, NORM_EPS, {}};
            pg8::gemm_phase<pg8::EpiBf16S, pg8::StaticOrder, PG8_ALIGN, PG8_SP2>(c.lds, gm, Sm, Em); }
        if (c.G == 256 && c.bx >= 144) {
            auto decode = [&](int it) -> CvtItem { return cvt_decode(T, it, c.lane); };
            cvt_run(decode, CVT_EARLY + (c.bx - 144) * NWAVES + c.wave, 112 * NWAVES, CVT_ALL, (LAS float*)(c.lds + c.wave * 16640), c.lane); } }
}
#ifndef ATT_LAYER
#define ATT_LAYER -1
#endif
#ifndef ATT_SEL
#define ATT_SEL 0
#endif
template <int L, int R = 0> __device__ __forceinline__ void ph_attn(const Ctx& c) {
    const Ptrs& T = c.T;
    volatile LAS int* flags = (volatile LAS int*)(c.MISC + 16);
    if (R == 0 || ATT_SEL == 0 || ATT_SEL == 1) {
    if constexpr (L % 2 == 0) {
        for (int u = c.vcu; u < BATCH * SB_HEADS * 16; u += c.G) { const int bh = u >> 4, qb = (u + (u >> 8) * 5) & 15;
            att::sb_unit(c.lds, flags, T.ACT, SB_IN_W, 0, TOK_W, 2 * TOK_W, T.MIX, bh / SB_HEADS, bh % SB_HEADS, qb); }
    } else {
        for (int u = c.vcu; u < BATCH * SWA_KV_HEADS * (SEQ / 64); u += c.G) { const int qi = u & 63, bk = u >> 6;
            att::swa_unit(c.lds, T.ACT, IN1_ROWS, T.sinks, T.MIX, bk / SWA_KV_HEADS, bk % SWA_KV_HEADS, qi); }
    } }
    if (R == 0 || ATT_SEL == 0 || ATT_SEL == 2) {
    constexpr int ldp = (L % 2 == 0) ? SB_IN_W : IN1_ROWS, qmc = (L % 2 == 0) ? 3 * TOK_W : TOK_W + 384;
    for (int u = c.vcu; u < BATCH * MEM_HEADS * 16; u += c.G)
        att::mem_unit(c.lds, T.ACT, ldp, qmc, T.KVM + (size_t)L * MROWS * 2 * MEM_W, T.memq_g + L * MEM_HD, T.memk_g + L * MEM_HD, T.MIX, u >> 6, (u >> 4) & 3, u & 15); }
}
template <int L, int R = 0> __device__ __forceinline__ void ph_outproj(const Ctx& c) {
    const Ptrs& T = c.T; pg8::Gemm g{T.MIX, T.WOUT + (size_t)L * D_MODEL * D_MODEL, M, D_MODEL, D_MODEL}; pg8::StaticOrder S; S.init(M, D_MODEL, c.G, c.bx, RES_WGM);
    pg8::EpiResidB<false> E{T.XB, T.out, T.SS, (LAS float*)(c.lds + TAB_OFF), D_MODEL, R == 0 ? 1.0f : 0.f};
    pg8::gemm_phase<pg8::EpiResidB<false>, pg8::StaticOrder, true, PG8_SP2>(c.lds, g, S, E);
}
template <int L> __device__ __forceinline__ void layer_phases(const Ctx& c, int pb) {
    RUN_PHASE(pb + 0, REP_GU, ph_up<2 * L>(c), ph_up<2 * L>(c)); SEAM(pb + 0);
    RUN_PHASE(pb + 1, REP_RS, (ph_down<2 * L, 0>(c)), (ph_down<2 * L, 1>(c))); SEAM(pb + 1);
    RUN_PHASE(pb + 2, REP_PJ, ph_inproj<L>(c), ph_inproj<L>(c)); SEAM(pb + 2);
    RUN_PHASE(pb + 3, (ATT_LAYER < 0 || ATT_LAYER == L ? REP_AT : 1), (ph_attn<L, 0>(c)), (ph_attn<L, 1>(c))); SEAM(pb + 3);
    RUN_PHASE(pb + 4, REP_RS, (ph_outproj<L, 0>(c)), (ph_outproj<L, 1>(c))); SEAM(pb + 4);
    RUN_PHASE(pb + 5, REP_GU, ph_up<2 * L + 1>(c), ph_up<2 * L + 1>(c)); SEAM(pb + 5);
    RUN_PHASE(pb + 6, (2 * L + 1 == 2 * DEPTH - 1 ? 1 : REP_RS), (ph_down<2 * L + 1, 0>(c)), (ph_down<2 * L + 1, 1>(c))); SEAM(pb + 6);
}
__global__ void __launch_bounds__(NWAVES * 64, 2) mk_fwd(Args args) {
    extern __shared__ __attribute__((aligned(16))) unsigned char lds_raw[];
    Ctx c;
    c.lds = (LAS unsigned char*)lds_raw;
    c.MISC = (volatile LAS unsigned*)(c.lds + MISC_OFF);
    const int tid = threadIdx.x;
    c.lane = tid & 63; c.wave = __builtin_amdgcn_readfirstlane(tid >> 6);
    c.G = gridDim.x; c.bx = blockIdx.x;
    const int vcu = (c.G % 8 == 0) ? (c.bx % 8) * (c.G / 8) + c.bx / 8 : c.bx;
    c.vcu = vcu; c.gw = vcu * NWAVES + c.wave; c.ngw = c.G * NWAVES;
    unsigned char* ws = args.ws;
    unsigned* ctl = (unsigned*)(ws + WS_CTL);
    Ptrs& T = c.T;
    T.x_in = (const float*)args.in[0]; T.mem = (const float*)args.in[1]; T.pos = (const int*)args.in[2]; T.ffn_g = (const float*)args.in[3];
    T.w_gate = (const float*)args.in[4]; T.w_up = (const float*)args.in[5]; T.w_down = (const float*)args.in[6]; T.mix_g = (const float*)args.in[7];
    T.mem_g = (const float*)args.in[8]; T.w_mkv = (const float*)args.in[9]; T.memq_g = (const float*)args.in[10]; T.memk_g = (const float*)args.in[11];
    T.w_out = (const float*)args.in[12]; T.w_in0 = (const float*)args.in[13]; T.w_in1 = (const float*)args.in[14]; T.swa_qg = (const float*)args.in[15];
    T.swa_kg = (const float*)args.in[16]; T.sinks = (const float*)args.in[17];
    T.out = args.out;
    T.WGU = (bf16*)(ws + WS_WGU); T.WD = (bf16*)(ws + WS_WD); T.WIN0 = (bf16*)(ws + WS_WIN0); T.WIN1 = (bf16*)(ws + WS_WIN1); T.WOUT = (bf16*)(ws + WS_WOUT); T.WMKV = (bf16*)(ws + WS_WMKV);
    T.XB = (bf16*)(ws + WS_XB); T.ACT = (bf16*)(ws + WS_ACT); T.MIX = (bf16*)(ws + WS_MIX); T.MEMN = (bf16*)(ws + WS_MEMN); T.KVM = (bf16*)(ws + WS_KVM);
    T.SS = (float*)(ws + WS_SS);
    for (int u = tid; u < (LDS_BYTES - MISC_OFF) / 4; u += NWAVES * 64) ((LAS unsigned*)(c.lds + MISC_OFF))[u] = 0u;
    __syncthreads();
    c.bar.bar = ctl + CW_BAR; c.bar.x = 0; c.bar.st = nullptr;
    if (!MK_SPLIT) c.bar = xcd_barrier_post(ctl + CW_BAR, c.MISC + 8);
    c.lo = args.ph_lo; c.hi = args.ph_hi;

    RUN_PHASE(0, 1, p0a_prologue(T, c.lds, c.gw, c.ngw, c.wave, c.lane), p0a_prologue(T, c.lds, c.gw, c.ngw, c.wave, c.lane));
    SEAM(0);
    RUN_PHASE(1, REP_P0, p0b_prologue(T, c.lds, vcu, c.G, c.wave, c.lane), p0b_prologue(T, c.lds, vcu, c.G, c.wave, c.lane));
    SEAM(1);
    layer_phases<0>(c, 2);
    layer_phases<1>(c, 9);
    static_assert(DEPTH == 2 && NPHASE == 16, "phase program written out for two layers");
}
#undef IN
#undef SEAM
#undef RUN_PHASE
#undef REPBAR

extern "C" void kernel_launch(void* const* d_in, const int* in_sizes, int n_in, void* d_out, int out_size, void* d_ws, size_t ws_size, hipStream_t stream) {
    static int grid = 0;
    if (grid == 0) {
        if (n_in != 18 || out_size != M * D_MODEL || ws_size < WS_END) { fprintf(stderr, "kernel_launch: unexpected shapes (n_in %d out %d ws %zu need %zu)\n", n_in, out_size, ws_size, (size_t)WS_END); grid = -1; return; }
        int dev = 0, cus = 0, per_cu = 0;
        if (hipGetDevice(&dev) != hipSuccess || hipDeviceGetAttribute(&cus, hipDeviceAttributeMultiprocessorCount, dev) != hipSuccess) { grid = -1; return; }
        if (hipFuncSetAttribute((const void*)mk_fwd, hipFuncAttributeMaxDynamicSharedMemorySize, LDS_BYTES) != hipSuccess) { fprintf(stderr, "kernel_launch: hipFuncSetAttribute failed\n"); grid = -1; return; }
        if (hipOccupancyMaxActiveBlocksPerMultiprocessor(&per_cu, (const void*)mk_fwd, NWAVES * 64, LDS_BYTES) != hipSuccess || per_cu < 1) fprintf(stderr, "kernel_launch: occupancy query reports %d\n", per_cu);
        (void)hipGetLastError();
        grid = cus;
    }
    if (grid < 0) return;
    if (hipMemsetAsync((char*)d_ws + WS_CTL + (size_t)CW_BAR * 4, 0, (size_t)XCD_BAR_WORDS * 4, stream) != hipSuccess) return;
    Args a; memset(&a, 0, sizeof(a));
    for (int i = 0; i < 18; ++i) a.in[i] = d_in[i];
    a.out = (float*)d_out; a.ws = (unsigned char*)d_ws;
#if MK_SPLIT
    for (int p = 0; p < NPHASE; ++p) { a.ph_lo = p; a.ph_hi = p + 1; a.li = p; hipLaunchKernelGGL(mk_fwd, dim3(grid), dim3(NWAVES * 64), LDS_BYTES, stream, a); }
#else
    a.ph_lo = 0; a.ph_hi = NPHASE; a.li = 0;
    hipLaunchKernelGGL(mk_fwd, dim3(grid), dim3(NWAVES * 64), LDS_BYTES, stream, a);
#endif
}
```
